# Optimizing an MI355X kernel written in HIP

```python
import jax, jax.numpy as jnp
from jax import lax
import numpy as np

D_MODEL = 2048
BATCH = 4
SEQ = 8192
DEPTH = 4

CTX_LEN = 256
GRID_W = 64
MIX_W = 2 * D_MODEL
SSD_W = MIX_W // 2
SSD_HEADS = 32
SSD_HEAD_DIM = SSD_W // SSD_HEADS
SSD_GROUPS = 8
SSD_STATE = 128
SSD_CHUNK = 128
CONV_W = 5
MLP_W = MIX_W - SSD_W
MLP_GROUPS = 16
MLP_GROUP_DIM = MLP_W // MLP_GROUPS
MLP_CHUNK = 128
GN = SSD_GROUPS * SSD_STATE
XBC_W = SSD_W + 2 * GN
DT_W = 2 * SSD_HEADS
IN_W = XBC_W + DT_W + SSD_W + 3 * MLP_W
EPS = 1e-6

kernel_name = "hybrid_ssd_chunkmlp_prefix_dit"


def _rmsnorm(x, g):
    xf = x.astype(jnp.float32)
    r = lax.rsqrt(jnp.mean(xf * xf, axis=-1, keepdims=True) + EPS)
    return (xf * r).astype(x.dtype) * g


def _dwconv_rows(x, w, b, n_rows, row_len):
    bsz, L, C = x.shape
    pad = CONV_W // 2
    xp = jnp.pad(x.reshape(bsz, n_rows, row_len, C), ((0, 0), (0, 0), (pad, pad), (0, 0)))
    y = b
    for k in range(CONV_W):
        y = y + xp[:, :, k:k + row_len] * w[k]
    return y.reshape(bsz, L, C)


def _ssd(xh, dt, A, Bm, Cm, h0, with_output):
    f32 = jnp.float32
    bsz, L, H, P = xh.shape
    G, N, Q = SSD_GROUPS, SSD_STATE, SSD_CHUNK
    R = H // G
    nc = L // Q
    x = xh.astype(f32).reshape(bsz, nc, Q, G, R, P)
    dtc = dt.reshape(bsz, nc, Q, G, R)
    a = dtc * A.reshape(G, R)
    xdt = x * dtc[..., None]
    Bc = Bm.astype(f32).reshape(bsz, nc, Q, G, N)
    Cc = Cm.astype(f32).reshape(bsz, nc, Q, G, N)
    acs = jnp.cumsum(a, axis=2)
    a_tot = acs[:, :, -1]
    decay_to_end = jnp.exp(a_tot[:, :, None] - acs)
    states = jnp.einsum('bckgn,bckgr,bckgrp->bcgrpn', Bc, decay_to_end, xdt)

    def step(h, inp):
        s, at = inp
        return h * jnp.exp(at)[..., None, None] + s, h

    hT, h_starts = lax.scan(step, h0.reshape(bsz, G, R, P, N),
                            (jnp.moveaxis(states, 1, 0), jnp.moveaxis(a_tot, 1, 0)))
    final = hT.reshape(bsz, H, P, N)
    if not with_output:
        return None, final
    h_starts = jnp.moveaxis(h_starts, 0, 1)
    CB = jnp.einsum('bcqgn,bckgn->bcgqk', Cc, Bc)
    acs_t = jnp.moveaxis(acs, 2, -1)
    diff = acs_t[..., :, None] - acs_t[..., None, :]
    mask = jnp.tril(jnp.ones((Q, Q), dtype=bool))
    Lmat = jnp.exp(jnp.where(mask, diff, -jnp.inf))
    y_diag = jnp.einsum('bcgqk,bcgrqk,bckgrp->bcqgrp', CB, Lmat, xdt)
    y_off = jnp.einsum('bcqgn,bcgrpn,bcqgr->bcqgrp', Cc, h_starts, jnp.exp(acs))
    return (y_diag + y_off).reshape(bsz, L, H, P), final


def _ssd_prep(z, conv_w, conv_b, dt_bias, a_log, n_rows, row_len):
    bsz, L, _ = z.shape
    xbc = jax.nn.silu(_dwconv_rows(z[..., :XBC_W], conv_w, conv_b, n_rows, row_len))
    xh = xbc[..., :SSD_W].reshape(bsz, L, SSD_HEADS, SSD_HEAD_DIM)
    Bm = xbc[..., SSD_W:SSD_W + GN].reshape(bsz, L, SSD_GROUPS, SSD_STATE)
    Cm = xbc[..., SSD_W + GN:XBC_W].reshape(bsz, L, SSD_GROUPS, SSD_STATE)
    dt_raw = z[..., XBC_W:XBC_W + DT_W].astype(jnp.float32).reshape(bsz, L, 2, SSD_HEADS)
    dt = jax.nn.softplus(dt_raw + dt_bias.astype(jnp.float32))
    A = -jnp.exp(a_log.astype(jnp.float32))
    return xh, Bm, Cm, dt, A


def _ssd_bidir(xh, Bm, Cm, dt, A, h0f, h0b, with_output):
    flip = lambda t: jnp.flip(t, axis=1)
    y_f, h_f = _ssd(xh, dt[:, :, 0], A[0], Bm, Cm, h0f, with_output)
    y_b, h_b = _ssd(flip(xh), flip(dt[:, :, 1]), A[1], flip(Bm), flip(Cm), h0b, with_output)
    if not with_output:
        return None, h_f, h_b
    return y_f + flip(y_b), h_f, h_b


def _mix_out(z, xh, y_ssd, d_skip, g_ssd, g_v, w_s, b_s, g_mlp, w_out):
    bsz, L, _ = z.shape
    o = XBC_W + DT_W
    z_ssd = z[..., o:o + SSD_W]
    u = z[..., o + SSD_W:o + SSD_W + MLP_W]
    v = z[..., o + SSD_W + MLP_W:o + SSD_W + 2 * MLP_W]
    z_mlp = z[..., o + SSD_W + 2 * MLP_W:]
    y = (y_ssd + d_skip.astype(jnp.float32)[:, None] * xh.astype(jnp.float32))
    y = y.reshape(bsz, L, SSD_W).astype(z.dtype)
    y_a = _rmsnorm(y * jax.nn.silu(z_ssd), g_ssd)
    vn = _rmsnorm(v, g_v).reshape(bsz, L // MLP_CHUNK, MLP_CHUNK, MLP_GROUPS, MLP_GROUP_DIM)
    sg = jnp.einsum('gqk,bckgd->bcqgd', w_s, vn) + jnp.swapaxes(b_s, 0, 1)[:, :, None]
    y_b = _rmsnorm(u * sg.reshape(bsz, L, MLP_W) * jax.nn.silu(z_mlp), g_mlp)
    return jnp.concatenate([y_a, y_b], axis=-1) @ w_out


def setup_inputs(seed: int = 0) -> dict:
    key = jax.random.key(seed)
    ks = jax.random.split(key, 20)
    D = D_MODEL
    nrm = jax.random.normal
    x = nrm(ks[0], (BATCH, SEQ, D), jnp.float32)
    c = nrm(ks[1], (BATCH, D), jnp.float32)
    ctx = nrm(ks[2], (BATCH, CTX_LEN, D), jnp.float32)
    c_ctx = nrm(ks[3], (D,), jnp.float32)
    w_ada = nrm(ks[4], (DEPTH, D, 3 * D), jnp.float32) * (0.5 * D ** -0.5)
    b_ada = 0.01 * nrm(ks[5], (DEPTH, 3 * D), jnp.float32)
    g_pre = 1.0 + 0.05 * nrm(ks[6], (DEPTH, D), jnp.float32)
    g_post = 1.0 + 0.05 * nrm(ks[7], (DEPTH, D), jnp.float32)
    w_in = nrm(ks[8], (DEPTH, D, IN_W), jnp.float32) * D ** -0.5
    conv_w = nrm(ks[9], (DEPTH, CONV_W, XBC_W), jnp.float32) * CONV_W ** -0.5
    conv_b = 0.01 * nrm(ks[10], (DEPTH, XBC_W), jnp.float32)
    u_dt = jax.random.uniform(ks[11], (DEPTH, 2, SSD_HEADS), jnp.float32)
    dt0 = jnp.exp(u_dt * (np.log(0.1) - np.log(0.001)) + np.log(0.001))
    dt_bias = dt0 + jnp.log(-jnp.expm1(-dt0))
    a_log = jnp.log(jax.random.uniform(ks[12], (DEPTH, 2, SSD_HEADS), jnp.float32, 1.0, 16.0))
    d_skip = 1.0 + 0.1 * nrm(ks[13], (DEPTH, SSD_HEADS), jnp.float32)
    g_ssd = 1.0 + 0.05 * nrm(ks[14], (DEPTH, SSD_W), jnp.float32)
    g_v = 1.0 + 0.05 * nrm(ks[15], (DEPTH, MLP_W), jnp.float32)
    w_s = nrm(ks[16], (DEPTH, MLP_GROUPS, MLP_CHUNK, MLP_CHUNK), jnp.float32) * (0.5 * MLP_CHUNK ** -0.5)
    b_s = 1.0 + 0.05 * nrm(ks[17], (DEPTH, MLP_GROUPS, MLP_CHUNK), jnp.float32)
    g_mlp = 1.0 + 0.05 * nrm(ks[18], (DEPTH, MLP_W), jnp.float32)
    w_out = nrm(ks[19], (DEPTH, MIX_W, D), jnp.float32) * MIX_W ** -0.5
    return {"x": x, "c": c, "ctx": ctx, "c_ctx": c_ctx, "w_ada": w_ada, "b_ada": b_ada,
            "g_pre": g_pre, "g_post": g_post, "w_in": w_in, "conv_w": conv_w, "conv_b": conv_b,
            "dt_bias": dt_bias, "a_log": a_log, "d_skip": d_skip, "g_ssd": g_ssd, "g_v": g_v,
            "w_s": w_s, "b_s": b_s, "g_mlp": g_mlp, "w_out": w_out}


def reference(x, c, ctx, c_ctx, w_ada, b_ada, g_pre, g_post, w_in, conv_w, conv_b,
              dt_bias, a_log, d_skip, g_ssd, g_v, w_s, b_s, g_mlp, w_out):
    bsz, L, _ = x.shape
    ROWS = L // GRID_W
    sc = jax.nn.silu(c)
    scc = jax.nn.silu(c_ctx)
    h0 = jnp.zeros((bsz, SSD_HEADS, SSD_HEAD_DIM, SSD_STATE), jnp.float32)
    for l in range(DEPTH):
        last = l == DEPTH - 1
        shift, scale, gate = jnp.split(sc @ w_ada[l] + b_ada[l], 3, axis=-1)
        shift_c, scale_c, gate_c = jnp.split(scc @ w_ada[l] + b_ada[l], 3, axis=-1)
        hc = _rmsnorm(ctx, g_pre[l]) * (1.0 + scale_c) + shift_c
        zc = hc @ (w_in[l][:, :XBC_W + DT_W] if last else w_in[l])
        xh_c, B_c, C_c, dt_c, A = _ssd_prep(zc, conv_w[l], conv_b[l], dt_bias[l], a_log[l], 1, CTX_LEN)
        y_c, h_f, h_b = _ssd_bidir(xh_c, B_c, C_c, dt_c, A, h0, h0, not last)
        hx = _rmsnorm(x, g_pre[l]) * (1.0 + scale[:, None]) + shift[:, None]
        zx = hx @ w_in[l]
        xh, Bm, Cm, dt, A = _ssd_prep(zx, conv_w[l], conv_b[l], dt_bias[l], a_log[l], ROWS, GRID_W)
        y_x, _, _ = _ssd_bidir(xh, Bm, Cm, dt, A, h_f, h_b, True)
        out = _rmsnorm(_mix_out(zx, xh, y_x, d_skip[l], g_ssd[l], g_v[l], w_s[l], b_s[l],
                                g_mlp[l], w_out[l]), g_post[l])
        x = x + gate[:, None] * out
        if not last:
            out_c = _rmsnorm(_mix_out(zc, xh_c, y_c, d_skip[l], g_ssd[l], g_v[l], w_s[l], b_s[l],
                                      g_mlp[l], w_out[l]), g_post[l])
            ctx = ctx + gate_c * out_c
    return x
```

```cpp
#include <hip/hip_runtime.h>
#include <hip/hip_cooperative_groups.h>
#include <cstdio>
#include <cstdint>
namespace cg = cooperative_groups;

#define LAS __attribute__((address_space(3)))
typedef unsigned short bf16_t;
typedef short bf16x8 __attribute__((ext_vector_type(8)));
typedef float f32x4 __attribute__((ext_vector_type(4)));
typedef float f32x2 __attribute__((ext_vector_type(2)));
typedef unsigned u32x4 __attribute__((ext_vector_type(4)));
typedef unsigned u32x2 __attribute__((ext_vector_type(2)));

constexpr int D = 2048, NB = 4, SEQ = 8192, DEPTH = 4, CTXL = 256;
constexpr int TCTX = NB * CTXL;
constexpr int T = TCTX + NB * SEQ;
constexpr int NCH = T / 128;
constexpr int ZW = 12544;
constexpr int ZC_ZSSD = 4096, ZC_U = 6144, ZC_V = 8192, ZC_ZMLP = 10240, ZC_DT = 12288;
constexpr int INW = 12352;
constexpr float EPS = 1e-6f;
constexpr int LDS_BAR_OFF = 161280;
constexpr int LDS_BYTES = 161296;
#ifndef REP_MASK
#define REP_MASK 0
#endif

constexpr size_t WS_BAR = 0;
constexpr size_t WS_MOD = 16384;
constexpr size_t WS_WSB = WS_MOD + 491520;
constexpr size_t WS_RVS = WS_WSB + 2097152;
constexpr size_t WS_YBS = WS_RVS + (size_t)T * 4;
constexpr size_t WS_DT = WS_YBS + (size_t)T * 4;
constexpr size_t WS_CTX = WS_DT + (size_t)T * 64 * 4;
constexpr size_t WS_WIN = WS_CTX + (size_t)TCTX * D * 4;
constexpr size_t WS_WOUT = WS_WIN + (size_t)4 * ZW * D * 2;
constexpr size_t WS_HX = WS_WOUT + (size_t)4 * 2048 * 4096 * 2;
constexpr size_t WS_Z = WS_HX + (size_t)T * D * 2;
constexpr size_t WS_XBC = WS_Z + (size_t)T * ZW * 2;
constexpr size_t WS_END = WS_XBC + (size_t)T * 4096 * 2;

struct Args { const float* in[20]; float* out; unsigned char* ws; int ph_lo, ph_hi; };

__device__ __forceinline__ unsigned cvt_pk_bf16(float lo, float hi) { unsigned r; asm volatile("v_cvt_pk_bf16_f32 %0, %1, %2" : "=v"(r) : "v"(lo), "v"(hi)); return r; }
__device__ __forceinline__ float bflo(unsigned u) { return __builtin_bit_cast(float, u << 16); }
__device__ __forceinline__ float bfhi(unsigned u) { return __builtin_bit_cast(float, u & 0xffff0000u); }
__device__ __forceinline__ float bf1(bf16_t h) { return __builtin_bit_cast(float, ((unsigned)h) << 16); }
template <int CTRL, int ROWMASK> __device__ __forceinline__ float dpp_get0(float v) { return __builtin_bit_cast(float, __builtin_amdgcn_update_dpp(0, __builtin_bit_cast(int, v), CTRL, ROWMASK, 0xf, true)); }
__device__ __forceinline__ float wave_incl_scan(float v) {
    v += dpp_get0<0x111, 0xf>(v); v += dpp_get0<0x112, 0xf>(v); v += dpp_get0<0x114, 0xf>(v); v += dpp_get0<0x118, 0xf>(v);
    v += dpp_get0<0x142, 0xa>(v);
    v += dpp_get0<0x143, 0xc>(v);
    return v;
}
__device__ __forceinline__ float wave_sum(float v) {
    return __builtin_bit_cast(float, __builtin_amdgcn_readlane(__builtin_bit_cast(int, wave_incl_scan(v)), 63));
}
__device__ __forceinline__ float silu_f(float x) { return x * __builtin_amdgcn_rcpf(1.f + __expf(-x)); }
__device__ __forceinline__ void unpack8(const u32x4 v, float* f) {
    f[0] = bflo(v.x); f[1] = bfhi(v.x); f[2] = bflo(v.y); f[3] = bfhi(v.y); f[4] = bflo(v.z); f[5] = bfhi(v.z); f[6] = bflo(v.w); f[7] = bfhi(v.w);
}
__device__ __forceinline__ u32x4 pack8(const float* f) {
    u32x4 w; w.x = cvt_pk_bf16(f[0], f[1]); w.y = cvt_pk_bf16(f[2], f[3]); w.z = cvt_pk_bf16(f[4], f[5]); w.w = cvt_pk_bf16(f[6], f[7]); return w;
}
__device__ __forceinline__ const float* inp_(const float* p) { long zo = 0; asm volatile("" : "+s"(zo)); return p + zo; }
#define INP(k) inp_(a.in[k])
typedef short s16x4 __attribute__((ext_vector_type(4)));
__device__ __forceinline__ bf16x8 ldfrag_tr(LAS const unsigned char* base, const int pitch, const int krow0, const int col0, const int lane) {
    const int g = lane >> 4, q = (lane & 15) >> 2, p = lane & 3;
    LAS const unsigned char* a0 = base + (krow0 + 8 * g + q) * pitch + (col0 + 4 * p) * 2;
    const s16x4 lo = __builtin_amdgcn_ds_read_tr16_b64_v4i16((LAS s16x4*)a0);
    const s16x4 hi = __builtin_amdgcn_ds_read_tr16_b64_v4i16((LAS s16x4*)(a0 + 4 * pitch));
    return (bf16x8){lo.x, lo.y, lo.z, lo.w, hi.x, hi.y, hi.z, hi.w};
}
__device__ __forceinline__ int offb(const int row, const int ch) { return 256 * row + 16 * (ch ^ (((row & 3) << 2) | ((row >> 2) & 3))); }
__device__ __forceinline__ int offx(const int row, const int ch) { return 128 * row + 16 * (ch ^ ((((row >> 1) & 1) << 1) | (((row >> 3) & 1) << 2))); }
__device__ __forceinline__ bf16x8 ldfrag_tr_b(LAS const unsigned char* base, const int krow0, const int c, const int lane) {
    const int g = lane >> 4, q = (lane & 15) >> 2, p = lane & 3, row = krow0 + 8 * g + q;
    const s16x4 lo = __builtin_amdgcn_ds_read_tr16_b64_v4i16((LAS s16x4*)(base + offb(row, 2 * c + (p >> 1)) + 8 * (p & 1)));
    const s16x4 hi = __builtin_amdgcn_ds_read_tr16_b64_v4i16((LAS s16x4*)(base + offb(row + 4, 2 * c + (p >> 1)) + 8 * (p & 1)));
    return (bf16x8){lo.x, lo.y, lo.z, lo.w, hi.x, hi.y, hi.z, hi.w};
}
__device__ __forceinline__ bf16x8 ldfrag_tr_bp(LAS const unsigned char* base, const int krow0, const int c, const int lane) {
    const int g = lane >> 4, q = (lane & 15) >> 2, p = lane & 3, row = krow0 + 8 * g + q, ch = 4 * (c >> 1) + p, b8 = 8 * (c & 1);
    const s16x4 lo = __builtin_amdgcn_ds_read_tr16_b64_v4i16((LAS s16x4*)(base + offb(row, ch) + b8));
    const s16x4 hi = __builtin_amdgcn_ds_read_tr16_b64_v4i16((LAS s16x4*)(base + offb(row + 4, ch) + b8));
    return (bf16x8){lo.x, lo.y, lo.z, lo.w, hi.x, hi.y, hi.z, hi.w};
}
__device__ __forceinline__ bf16x8 ldfrag_tr_x(LAS const unsigned char* base, const int krow0, const int c, const int lane) {
    const int g = lane >> 4, q = (lane & 15) >> 2, p = lane & 3, row = krow0 + 8 * g + q;
    LAS const unsigned char* a0 = base + offx(row, 2 * c + (p >> 1)) + 8 * (p & 1);
    const s16x4 lo = __builtin_amdgcn_ds_read_tr16_b64_v4i16((LAS s16x4*)a0);
    const s16x4 hi = __builtin_amdgcn_ds_read_tr16_b64_v4i16((LAS s16x4*)(a0 + 512));
    return (bf16x8){lo.x, lo.y, lo.z, lo.w, hi.x, hi.y, hi.z, hi.w};
}
#define LDS_BARRIER() do { asm volatile("s_waitcnt lgkmcnt(0)" ::: "memory"); __builtin_amdgcn_s_barrier(); asm volatile("" ::: "memory"); } while (0)
#define MFMA16(a, b, c) __builtin_amdgcn_mfma_f32_16x16x32_bf16((a), (b), (c), 0, 0, 0)

namespace pg8 {
constexpr int BM = 256, BK = 64, HALF = 128, HTB = HALF * BK * 2, STAGE_BYTES = 8 * HTB, NXCD = 8, WGM = 8;
__device__ __forceinline__ int lds_byte(int r, int c) { const int st = (r >> 4) * 2 + (c >> 5), rr = r & 15, cc = c & 31, ob = rr * 64 + cc * 2; return st * 1024 + (ob ^ (((ob >> 9) & 1) << 5)); }
__device__ __forceinline__ void stage_rc(int b, int& R, int& C) { const int st = b / 1024, sb = b % 1024, swz = sb ^ (((sb >> 9) & 1) << 5); R = (st >> 1) * 16 + swz / 64; C = (st & 1) * 32 + (swz % 64) / 2; }
__device__ __forceinline__ int perm32(int rho) { const int n = rho >> 4, i = rho & 15; return 8 * (i >> 2) + 4 * n + (i & 3); }
struct Unit { int pm, pn, kc; };
struct Gemm { const bf16_t* A; const bf16_t* Bt; int M, N, K, lda; const bf16_t* A2; float* P2; };
struct StaticOrder {
    int nM, nN, nwg, G, c, tail;
    __device__ void init(int M, int N, int G_, int c_, int tail_) { nM = M / BM; nN = N / BM; nwg = nM * nN; G = G_; c = c_; tail = tail_; }
    __device__ bool next(int i, Unit& u) const {
        const long L = (long)i * G + c;
        if (L >= nwg) { const long t = L - nwg; if (!tail || t >= 256) return false; u.pm = (int)(t >> 6); u.pn = (int)(t >> 3) & 7; u.kc = (int)t & 7; return true; }
        u.kc = -1;
        int wgid = (int)L; { const int q = nwg / NXCD, r = nwg % NXCD, xcd = wgid % NXCD, off = wgid / NXCD; wgid = (xcd < r ? xcd * (q + 1) : r * (q + 1) + (xcd - r) * q) + off; }
        const int nig = WGM * nN, gid = wgid / nig, fm = gid * WGM, gsz = (nM - fm) < WGM ? (nM - fm) : WGM;
        u.pm = fm + ((wgid % nig) % gsz); u.pn = (wgid % nig) / gsz; return true;
    }
};
struct EpiF32 {
    static constexpr bool PERM = false;
    float* C; int ldc;
    __device__ __forceinline__ void operator()(const f32x4 (&acc)[2][2][4][2], const Unit& u, int wr, int wc, int fr, int fq) const {
        const int row0 = u.pm * BM + wr * 64 + fr, col0 = u.pn * BM + wc * 32 + 4 * fq;
#pragma unroll
        for (int ai = 0; ai < 2; ++ai)
#pragma unroll
            for (int m = 0; m < 4; ++m) { float* rowp = C + (size_t)(row0 + ai * HALF + m * 16) * ldc + col0;
#pragma unroll
                for (int bj = 0; bj < 2; ++bj)
#pragma unroll
                    for (int n = 0; n < 2; ++n) *(f32x4*)(rowp + bj * HALF + n * 16) = acc[ai][bj][m][n]; }
    }
};
struct EpiF32Perm {
    float* C; int ldc;
    __device__ __forceinline__ void operator()(const f32x4 (&acc)[2][2][4][2], const Unit& u, int wr, int wc, int fr, int fq) const {
        const int row0 = u.pm * BM + wr * 64 + fr, col0 = u.pn * BM + wc * 32 + 8 * fq;
#pragma unroll
        for (int ai = 0; ai < 2; ++ai)
#pragma unroll
            for (int m = 0; m < 4; ++m) { float* rowp = C + (size_t)(row0 + ai * HALF + m * 16) * ldc + col0;
#pragma unroll
                for (int bj = 0; bj < 2; ++bj) { *(f32x4*)(rowp + bj * HALF) = acc[ai][bj][m][0]; *(f32x4*)(rowp + bj * HALF + 4) = acc[ai][bj][m][1]; } }
    }
};
struct EpiBf16 {
    static constexpr bool PERM = true;
    bf16_t* O; int ldc;
    __device__ __forceinline__ void operator()(const f32x4 (&acc)[2][2][4][2], const Unit& u, int wr, int wc, int fr, int fq) const {
        const int row0 = u.pm * BM + wr * 64 + fr, col0 = u.pn * BM + wc * 32 + 8 * fq;
#pragma unroll
        for (int ai = 0; ai < 2; ++ai)
#pragma unroll
            for (int m = 0; m < 4; ++m) { bf16_t* rowp = O + (size_t)(row0 + ai * HALF + m * 16) * ldc + col0;
#pragma unroll
                for (int bj = 0; bj < 2; ++bj) { const f32x4 v0 = acc[ai][bj][m][0], v1 = acc[ai][bj][m][1];
                    u32x4 w; w.x = cvt_pk_bf16(v0[0], v0[1]); w.y = cvt_pk_bf16(v0[2], v0[3]); w.z = cvt_pk_bf16(v1[0], v1[1]); w.w = cvt_pk_bf16(v1[2], v1[3]);
                    __builtin_nontemporal_store(w, (u32x4*)(rowp + bj * HALF)); } }
    }
};

__device__ __forceinline__ void gemm_phase(const int tid, LAS unsigned char* lds, const Gemm g, const StaticOrder& S, const int mode  , void* Cout, const int ldc, float* rvs, const float* rbs, const float* rbs_tail) {
    const int wid = __builtin_amdgcn_readfirstlane(tid >> 6), lane = tid & 63, wr = wid >> 2, wc = wid & 3, fr = lane & 15, fq = lane >> 4;
    const int K = g.K, nt = K / BK, lda = g.lda;
    unsigned voffA[2], voffB[2];
#pragma unroll
    for (int i = 0; i < 2; ++i) { int R, C; stage_rc(tid * 16 + i * 8192, R, C); const int Rb = (mode == 0) ? ((R & ~31) + perm32(R & 31)) : R;
        voffA[i] = (unsigned)(R * lda + C) * 2u; voffB[i] = (unsigned)(Rb * K + C) * 2u; }
    const size_t kstep = (size_t)(BK * 2);
    const size_t hstepA = (size_t)HALF * lda * 2, hstepB = (size_t)HALF * K * 2;
    const size_t tstepA = 2 * hstepA, tstepB = 2 * hstepB;
    const unsigned ldsw = (unsigned)wid * 1024u;
    const int aoff = lds_byte(wr * 64 + fr, fq * 8), boff = lds_byte(wc * 32 + fr, fq * 8);
#define PG8_SA(b, h) (((b) * 2 + (h)) * HTB)
#define PG8_SB(b, h) ((4 + (b) * 2 + (h)) * HTB)
#define PG8_STAGE(bufoff, gbase, voff) do { _Pragma("unroll") for (int _i = 0; _i < 2; ++_i) \
        __builtin_amdgcn_global_load_lds((const unsigned*)((const char*)(gbase) + (voff)[_i]), (LAS unsigned*)(lds + (bufoff) + ldsw + _i * 8192), 16, 0, 0); } while (0)
#define PG8_LDA(dst, b, h) do { _Pragma("unroll") for (int m = 0; m < 4; ++m) _Pragma("unroll") for (int k = 0; k < 2; ++k) dst[m][k] = *(const LAS bf16x8*)(lds + PG8_SA(b, h) + aoff + m * 2048 + k * 1024); } while (0)
#define PG8_LDB(dst, b, h) do { _Pragma("unroll") for (int n = 0; n < 2; ++n) _Pragma("unroll") for (int k = 0; k < 2; ++k) dst[n][k] = *(const LAS bf16x8*)(lds + PG8_SB(b, h) + boff + n * 2048 + k * 1024); } while (0)
#define PG8_MMA(ai, bj, At, Bt) do { __builtin_amdgcn_s_setprio(1); _Pragma("unroll") for (int m = 0; m < 4; ++m) _Pragma("unroll") for (int n = 0; n < 2; ++n) _Pragma("unroll") for (int k = 0; k < 2; ++k) \
        acc[ai][bj][m][n] = __builtin_amdgcn_mfma_f32_16x16x32_bf16(Bt[n][k], At[m][k], acc[ai][bj][m][n], 0, 0, 0); __builtin_amdgcn_s_setprio(0); } while (0)
#define PG8_WAIT_V(n) asm volatile("s_waitcnt vmcnt(" #n ")" ::: "memory")
#define PG8_WAIT_L(n) asm volatile("s_waitcnt lgkmcnt(" #n ")" ::: "memory")
#define PG8_BAR __builtin_amdgcn_s_barrier()
#define PG8_SCHED __builtin_amdgcn_sched_barrier(0)
    Unit cur, nxt; int ui = 0;
    if (!S.next(0, cur)) return;
    f32x4 acc[2][2][4][2];
#pragma unroll
    for (int a = 0; a < 2; ++a)
#pragma unroll
        for (int b = 0; b < 2; ++b)
#pragma unroll
            for (int m = 0; m < 4; ++m)
#pragma unroll
                for (int n = 0; n < 2; ++n) acc[a][b][m][n] = (f32x4){0.f, 0.f, 0.f, 0.f};
    bf16x8 At[4][2], B0[2][2], B1[2][2];
#define PG8_UA(u) ((u).kc < 0 ? (const char*)g.A + (size_t)(u).pm * tstepA : (const char*)g.A2 + (size_t)(u).pm * tstepA + (size_t)(u).kc * 1024)
#define PG8_UB(u) ((const char*)g.Bt + (size_t)(u).pn * tstepB + ((u).kc < 0 ? (size_t)0 : (size_t)(u).kc * 1024))
    const char* cA = PG8_UA(cur); const char* cB = PG8_UB(cur);
    PG8_STAGE(PG8_SB(0, 0), cB, voffB); PG8_STAGE(PG8_SB(0, 1), cB + hstepB, voffB); PG8_STAGE(PG8_SA(0, 0), cA, voffA); PG8_STAGE(PG8_SA(0, 1), cA + hstepA, voffA);
    if (wr == 1) PG8_BAR;
    PG8_WAIT_V(2); PG8_BAR;
    PG8_STAGE(PG8_SB(1, 0), cB + kstep, voffB); PG8_STAGE(PG8_SA(1, 0), cA + kstep, voffA); PG8_STAGE(PG8_SB(1, 1), cB + hstepB + kstep, voffB);
    PG8_WAIT_V(6); PG8_BAR;
    for (;;) {
        const bool has_next = S.next(ui + 1, nxt);
        const char* nA = has_next ? PG8_UA(nxt) : cA; const char* nB = has_next ? PG8_UB(nxt) : cB;
        const int ntu = cur.kc < 0 ? nt : 8;
        for (int t = 0; t < ntu; t += 2) {
            const bool last = (t == ntu - 2);
            const char* a1 = cA + (size_t)(t + 1) * kstep;
            const char* a2 = last ? nA : cA + (size_t)(t + 2) * kstep; const char* b2 = last ? nB : cB + (size_t)(t + 2) * kstep;
            const char* a3 = a2 + kstep; const char* b3 = b2 + kstep;
            PG8_LDB(B0, 0, 0); PG8_LDB(B1, 0, 1); PG8_SCHED; PG8_LDA(At, 0, 0); PG8_STAGE(PG8_SA(1, 1), a1 + hstepA, voffA);
            PG8_WAIT_V(8); PG8_WAIT_L(0); PG8_BAR; PG8_MMA(0, 0, At, B0); PG8_MMA(0, 1, At, B1); PG8_BAR; PG8_SCHED;
            PG8_LDA(At, 0, 1); PG8_STAGE(PG8_SB(0, 0), b2, voffB); PG8_STAGE(PG8_SB(0, 1), b2 + hstepB, voffB); PG8_STAGE(PG8_SA(0, 0), a2, voffA);
            PG8_WAIT_V(8); PG8_WAIT_L(0); PG8_BAR; PG8_MMA(1, 0, At, B0); PG8_MMA(1, 1, At, B1); PG8_BAR; PG8_SCHED;
            PG8_LDB(B0, 1, 0); PG8_LDB(B1, 1, 1); PG8_SCHED; PG8_LDA(At, 1, 0); PG8_STAGE(PG8_SA(0, 1), a2 + hstepA, voffA);
            PG8_WAIT_V(8); PG8_WAIT_L(0); PG8_BAR; PG8_MMA(0, 0, At, B0); PG8_MMA(0, 1, At, B1); PG8_BAR; PG8_SCHED;
            PG8_LDA(At, 1, 1); PG8_STAGE(PG8_SB(1, 0), b3, voffB); PG8_STAGE(PG8_SB(1, 1), b3 + hstepB, voffB); PG8_STAGE(PG8_SA(1, 0), a3, voffA);
            PG8_WAIT_V(8); PG8_WAIT_L(0); PG8_BAR; PG8_MMA(1, 0, At, B0); PG8_MMA(1, 1, At, B1); PG8_BAR; PG8_SCHED;
        }
        if (wr == 0) PG8_BAR;
        { const float* rp = cur.kc >= 0 ? rbs_tail : rbs;
          if (rp != nullptr) {
#pragma unroll
            for (int ai = 0; ai < 2; ++ai)
#pragma unroll
                for (int m = 0; m < 4; ++m) { const float rb = rsqrtf(rp[cur.pm * BM + ai * HALF + wr * 64 + m * 16 + fr] * (1.f / 2048.f) + EPS);
#pragma unroll
                    for (int bj = 0; bj < 2; ++bj)
#pragma unroll
                        for (int n = 0; n < 2; ++n) acc[ai][bj][m][n] = acc[ai][bj][m][n] * rb; } } }
        if (cur.kc >= 0) { EpiF32Perm E; E.C = g.P2 + (size_t)cur.kc * TCTX * 2048; E.ldc = 2048; E(acc, cur, wr, wc, fr, fq); }
        else if (mode == 0 && rvs != nullptr && ((cur.pn >= 24 && cur.pn < 32) || (cur.pn >= 40 && cur.pn < 48))) {
            const int j = cur.pn < 32 ? cur.pn - 24 : cur.pn - 32;
            bf16_t* O = (bf16_t*)Cout + ZC_U + 128 * j + wc * 32 + 8 * fq; const int row0 = cur.pm * BM + wr * 64 + fr;
#pragma unroll
            for (int ai = 0; ai < 2; ++ai)
#pragma unroll
                for (int m = 0; m < 4; ++m) { const f32x4 u0 = acc[ai][0][m][0], u1 = acc[ai][0][m][1], z0 = acc[ai][1][m][0], z1 = acc[ai][1][m][1];
                    u32x4 w; w.x = cvt_pk_bf16(u0[0] * silu_f(z0[0]), u0[1] * silu_f(z0[1])); w.y = cvt_pk_bf16(u0[2] * silu_f(z0[2]), u0[3] * silu_f(z0[3]));
                    w.z = cvt_pk_bf16(u1[0] * silu_f(z1[0]), u1[1] * silu_f(z1[1])); w.w = cvt_pk_bf16(u1[2] * silu_f(z1[2]), u1[3] * silu_f(z1[3]));
                    __builtin_nontemporal_store(w, (u32x4*)(O + (size_t)(row0 + ai * HALF + m * 16) * ldc)); } }
        else if (mode == 0) { EpiBf16 E; E.O = (bf16_t*)Cout; E.ldc = ldc; E(acc, cur, wr, wc, fr, fq);
            if (rvs != nullptr && (cur.pn >> 3) == 4) {
#pragma unroll
                for (int ai = 0; ai < 2; ++ai)
#pragma unroll
                    for (int m = 0; m < 4; ++m) { float ss = 0.f;
#pragma unroll
                        for (int bj = 0; bj < 2; ++bj)
#pragma unroll
                            for (int n = 0; n < 2; ++n) { const f32x4 v = acc[ai][bj][m][n]; ss += (v.x * v.x + v.y * v.y) + (v.z * v.z + v.w * v.w); }
                        ss += __shfl_xor(ss, 16); ss += __shfl_xor(ss, 32);
                        if (fq == 0) unsafeAtomicAdd(rvs + cur.pm * BM + ai * HALF + wr * 64 + m * 16 + fr, ss); } } }
        else { EpiF32 E; E.C = (float*)Cout; E.ldc = ldc; E(acc, cur, wr, wc, fr, fq); }
        if (!has_next) break;
#pragma unroll
        for (int a = 0; a < 2; ++a)
#pragma unroll
            for (int b = 0; b < 2; ++b)
#pragma unroll
                for (int m = 0; m < 4; ++m)
#pragma unroll
                    for (int n = 0; n < 2; ++n) acc[a][b][m][n] = (f32x4){0.f, 0.f, 0.f, 0.f};
        cur = nxt; cA = nA; cB = nB; ++ui;
        if (wr == 1) PG8_BAR;
    }
    PG8_WAIT_V(0);
    PG8_BAR;
#undef PG8_UA
#undef PG8_UB
#undef PG8_SA
#undef PG8_SB
#undef PG8_STAGE
#undef PG8_LDA
#undef PG8_LDB
#undef PG8_MMA
#undef PG8_WAIT_V
#undef PG8_WAIT_L
#undef PG8_BAR
#undef PG8_SCHED
}
}

#define XB_TMO      128
#define XB_XCNT(j)  (256  + 64 * (j))
#define XB_XSUB(j)  (1280 + 64 * (j))
#define XB_XGEN(j)  (2304 + 64 * (j))
#define XB_TOP      3328
#define XB_TOPGEN   3392
#define XCD_BAR_WORDS 3456
#define XB_SPIN_CAP (1u << 18)

__device__ __forceinline__ unsigned xb_ld(unsigned* p)              { return __hip_atomic_load(p, __ATOMIC_RELAXED, __HIP_MEMORY_SCOPE_AGENT); }
__device__ __forceinline__ unsigned xb_add(unsigned* p, unsigned v) { return __hip_atomic_fetch_add(p, v, __ATOMIC_RELAXED, __HIP_MEMORY_SCOPE_AGENT); }
__device__ __forceinline__ unsigned xb_xcc_id() { return (unsigned)__builtin_amdgcn_s_getreg((3 << 11) | 20) & 0xFu; }
#define XB_SPIN(cond, bar) do { unsigned _sp = 0; while (cond) { __builtin_amdgcn_s_sleep(1); \
    if ((++_sp & 255u) == 0u) { if (xb_ld(&(bar)[XB_TMO])) break; if (_sp > XB_SPIN_CAP) { atomicAdd(&(bar)[XB_TMO], 1u); break; } } } } while (0)

struct XcdBarrier {
    unsigned* bar; unsigned x;
    volatile LAS unsigned* st;
};

__device__ __forceinline__ XcdBarrier xcd_barrier_post(unsigned* bar, volatile LAS unsigned* st) {
    XcdBarrier b; b.bar = bar; b.x = xb_xcc_id(); b.st = st;
    if (threadIdx.x == 0) (void)xb_add(&bar[XB_XCNT(b.x)], 1u);
    return b;
}
__device__ __forceinline__ void xcd_barrier_complete(unsigned* bar, unsigned x, unsigned& nloc, unsigned& nx) {
    const unsigned G = gridDim.x * gridDim.y * gridDim.z;
    unsigned sum, cnt, mine, sp = 0u;
    for (;;) {
        sum = 0u; cnt = 0u; mine = 0u;
#pragma unroll
        for (unsigned j = 0; j < 16; ++j) { const unsigned c = xb_ld(&bar[XB_XCNT(j)]); sum += c; cnt += (c > 0u) ? 1u : 0u; mine = (j == x) ? c : mine; }
        if (sum == G) break;
        __builtin_amdgcn_s_sleep(1);
        if ((++sp & 255u) == 0u) { if (xb_ld(&bar[XB_TMO])) break; if (sp > XB_SPIN_CAP) { atomicAdd(&bar[XB_TMO], 1u); break; } }
    }
    nloc = mine > 0u ? mine : 1u; nx = cnt > 0u ? cnt : 1u;
}

__device__ __forceinline__ void xcd_barrier(const XcdBarrier& b) {
    asm volatile("s_waitcnt vmcnt(0)" ::: "memory");
    __syncthreads();
    if (threadIdx.x == 0) {
        unsigned* bar = b.bar;
        __builtin_amdgcn_s_waitcnt(0);
        unsigned nloc = b.st[0], nx = b.st[1];
        if (nloc == 0u) { xcd_barrier_complete(bar, b.x, nloc, nx); b.st[0] = nloc; b.st[1] = nx; }
        const unsigned old = xb_add(&bar[XB_XSUB(b.x)], 1u);
        const unsigned gen = old / nloc;
        if (old + 1u == (gen + 1u) * nloc) {
            __builtin_amdgcn_fence(__ATOMIC_RELEASE, "agent");
            asm volatile("s_waitcnt vmcnt(0)" ::: "memory");
            const unsigned og = xb_add(&bar[XB_TOP], 1u);
            const unsigned tg = og / nx;
            if (og + 1u == (tg + 1u) * nx) xb_add(&bar[XB_TOPGEN], 1u);
            else XB_SPIN(xb_ld(&bar[XB_TOPGEN]) == tg, bar);
            __builtin_amdgcn_fence(__ATOMIC_ACQUIRE, "agent");
            xb_add(&bar[XB_XGEN(b.x)], 1u);
            asm volatile("s_waitcnt vmcnt(0)" ::: "memory");
        } else {
            XB_SPIN(xb_ld(&bar[XB_XGEN(b.x)]) == gen, bar);
            __builtin_amdgcn_fence(__ATOMIC_ACQUIRE, "agent");
            asm volatile("s_waitcnt vmcnt(0)" ::: "memory");
        }
    }
    __syncthreads();
}


__device__ __forceinline__ void transpose_item(const float* W, int ldw, int srcc0, int k0, bf16_t* WT, int ldk, int n0, bool zero, LAS float* scr, int lane, const float* kscale = nullptr) {
    if (!zero) {
        f32x4 v[8];
#pragma unroll
        for (int i = 0; i < 8; ++i) { const int kk = (lane >> 3) + 8 * i; v[i] = *(const f32x4*)(W + (size_t)(k0 + kk) * ldw + srcc0 + (lane & 7) * 4); }
#pragma unroll
        for (int i = 0; i < 8; ++i) { const int kk = (lane >> 3) + 8 * i; LAS float* d = scr + kk * 33 + (lane & 7) * 4; const float sc = kscale ? kscale[kk] : 1.f; d[0] = v[i].x * sc; d[1] = v[i].y * sc; d[2] = v[i].z * sc; d[3] = v[i].w * sc; }
    }
    asm volatile("s_waitcnt lgkmcnt(0)" ::: "memory");
    const int c = lane & 7;
#pragma unroll
    for (int j = 0; j < 4; ++j) { const int n = (lane >> 3) + 8 * j; const LAS float* s = scr + (8 * c) * 33 + n;
        u32x4 o;
        if (zero) { o = (u32x4){0u, 0u, 0u, 0u}; }
        else { o.x = cvt_pk_bf16(s[0 * 33], s[1 * 33]); o.y = cvt_pk_bf16(s[2 * 33], s[3 * 33]); o.z = cvt_pk_bf16(s[4 * 33], s[5 * 33]); o.w = cvt_pk_bf16(s[6 * 33], s[7 * 33]); }
        *(u32x4*)(WT + (size_t)(n0 + n) * ldk + k0 + 8 * c) = o; }
    asm volatile("s_waitcnt lgkmcnt(0)" ::: "memory");
}

__device__ __forceinline__ void convert_layer_weights(const Args& a, unsigned char* ws, const int l, const int gw, const int NGW, LAS unsigned char* lds, const int wave, const int lane) {
    LAS float* scr = (LAS float*)(lds + wave * 16384);
    constexpr int I_IN = 32 * 392, I_OUT = 64 * 64;
    bf16_t* WinT = (bf16_t*)(ws + WS_WIN); bf16_t* WoutT = (bf16_t*)(ws + WS_WOUT);
    for (int it = gw; it < I_IN + I_OUT; it += NGW) {
        if (it < I_IN) {
            const int kb = it / 392, nb = it % 392, n0 = nb * 32;
            int src; bool zero = false;
            if (n0 < 4096) src = n0; else if (n0 < 6144) src = 4160 + (n0 - 4096);
            else if (n0 < 8192 || (n0 >= 10240 && n0 < 12288)) {
                const int rel = n0 < 8192 ? n0 - 6144 : n0 - 10240 + 2048, j = rel >> 8, cc = rel & 255; src = cc < 128 ? 6208 + 128 * j + cc : 10304 + 128 * j + (cc - 128); }
            else if (n0 < 10240) src = 8256 + (n0 - 8192); else if (n0 < 12352) src = 4096 + (n0 - 12288); else { src = 0; zero = true; }
            transpose_item(INP(8) + (size_t)l * 2048 * INW, INW, src, kb * 64, WinT + (size_t)l * ZW * 2048, 2048, n0, zero, scr, lane);
        } else {
            const int r = it - I_IN, kb = r / 64, nb = r % 64;
            transpose_item(INP(19) + (size_t)l * 4096 * 2048, 2048, nb * 32, kb * 64, WoutT + (size_t)l * 2048 * 4096, 4096, nb * 32, false, scr, lane, kb >= 32 ? INP(18) + l * 2048 + (kb * 64 - 2048) : (const float*)nullptr);
        }
    }
}

__device__ __forceinline__ void phase_prologue(const Args& a, unsigned char* ws, const int bid, LAS unsigned char* lds, int tid, int wave, int lane) {
    const int G = gridDim.x;
    {
        LAS float* sc = (LAS float*)lds;
        LAS float* part = (LAS float*)(lds + 40960);
        const float* c = INP(1); const float* cctx = INP(3);
        for (int i = tid; i < 5 * 2048; i += 512) { const int s = i >> 11, k = i & 2047; const float cv = s < 4 ? c[s * 2048 + k] : cctx[k]; sc[i] = silu_f(cv); }
        __syncthreads();
        float* mod = (float*)(ws + WS_MOD);
        for (int item = bid; item < 192; item += G) {
            const int l = item / 48, cb = item % 48, col0 = cb * 128;
            const float* W = INP(4) + (size_t)l * 2048 * 6144 + col0 + lane * 2;
            float acc[5][2];
#pragma unroll
            for (int s = 0; s < 5; ++s) { acc[s][0] = 0.f; acc[s][1] = 0.f; }
            const int k0 = wave * 256;
#pragma unroll 8
            for (int k = k0; k < k0 + 256; ++k) { const f32x2 w = *(const f32x2*)(W + (size_t)k * 6144);
#pragma unroll
                for (int s = 0; s < 5; ++s) { const float sv = sc[s * 2048 + k]; acc[s][0] += sv * w.x; acc[s][1] += sv * w.y; } }
#pragma unroll
            for (int s = 0; s < 5; ++s) { part[(wave * 5 + s) * 128 + lane * 2] = acc[s][0]; part[(wave * 5 + s) * 128 + lane * 2 + 1] = acc[s][1]; }
            __syncthreads();
            for (int i = tid; i < 640; i += 512) { const int s = i >> 7, cc = i & 127; float v = INP(5)[l * 6144 + col0 + cc];
#pragma unroll
                for (int w = 0; w < 8; ++w) v += part[(w * 5 + s) * 128 + cc];
                const int col = col0 + cc;
                if (col >= 4096) v *= INP(7)[l * 2048 + col - 4096]; else if (col >= 2048) v = (1.f + v) * INP(6)[l * 2048 + col - 2048];
                mod[(size_t)(l * 5 + s) * 6144 + col] = v; }
            __syncthreads();
        }
    }
    {
        bf16_t* wsb = (bf16_t*)(ws + WS_WSB); const float* w_s = INP(16);
        for (int i = (bid * 512 + tid) * 4; i < 4 * 16 * 16384; i += G * 512 * 4) { const f32x4 v = *(const f32x4*)(w_s + i);
            u32x2 o; o.x = cvt_pk_bf16(v.x, v.y); o.y = cvt_pk_bf16(v.z, v.w); *(u32x2*)(wsb + i) = o; }
    }
    convert_layer_weights(a, ws, 0, bid * 8 + wave, G * 8, lds, wave, lane);
}

__device__ __forceinline__ void phase_A(const Args& a, unsigned char* ws, const int bid, int l, int wave, int lane) {
    const int gw = bid * 8 + wave, NGW = gridDim.x * 8;
    const float* mod = (const float*)(ws + WS_MOD);
    float* ctxall = (float*)(ws + WS_CTX);
    bf16_t* hx = (bf16_t*)(ws + WS_HX);
    const bf16_t* z = (const bf16_t*)(ws + WS_Z);
#pragma unroll 1
    for (int seg = (l == 4 ? 1 : 0); seg < 5; ++seg) {
        const int s = seg == 0 ? 4 : seg - 1, rbeg = seg == 0 ? 0 : TCTX + (seg - 1) * SEQ, rend = seg == 0 ? TCTX : rbeg + SEQ;
        f32x4 G2[8], S2[8], SH[8];
        if (l >= 1) { const float* gp = mod + (size_t)((l - 1) * 5 + s) * 6144 + 4096 + lane * 4;
#pragma unroll
            for (int j = 0; j < 8; ++j) G2[j] = *(const f32x4*)(gp + j * 256); }
        if (l < 4) { const float* sp = mod + (size_t)(l * 5 + s) * 6144 + lane * 4;
#pragma unroll
            for (int j = 0; j < 8; ++j) { SH[j] = *(const f32x4*)(sp + j * 256); S2[j] = *(const f32x4*)(sp + 2048 + j * 256); } }
#pragma unroll 1
        for (int r = rbeg + gw; r < rend; r += NGW) {
            if (l < 4 && lane == 0) { ((float*)(ws + WS_RVS))[r] = 0.f; ((float*)(ws + WS_YBS))[r] = 0.f; }
            const float* src; float* dst;
            if (r < TCTX) { dst = ctxall + (size_t)r * D; src = (l <= 1) ? INP(2) + (size_t)r * D : dst; }
            else { dst = a.out + (size_t)(r - TCTX) * D; src = (l <= 1) ? INP(0) + (size_t)(r - TCTX) * D : dst; }
            f32x4 xv[8];
#pragma unroll
            for (int j = 0; j < 8; ++j) xv[j] = *(const f32x4*)(src + j * 256 + lane * 4);
            if (l >= 1) {
                const bf16_t* orow = z + (size_t)r * ZW;
                f32x4 ov[8]; float ss = 0.f;
                if (r < TCTX) {
                    const float* pp = (const float*)(ws + WS_XBC) + (size_t)r * 2048 + lane * 4;
#pragma unroll
                    for (int j = 0; j < 8; ++j) { f32x4 acc4 = *(const f32x4*)(pp + j * 256);
#pragma unroll
                        for (int kc = 1; kc < 8; ++kc) acc4 = acc4 + *(const f32x4*)(pp + (size_t)kc * TCTX * 2048 + j * 256);
                        ov[j] = acc4; }
                } else {
#pragma unroll
                    for (int j = 0; j < 8; ++j) { const u32x2 ob = *(const u32x2*)(orow + j * 256 + lane * 4); ov[j] = (f32x4){bflo(ob.x), bfhi(ob.x), bflo(ob.y), bfhi(ob.y)}; }
                }
#pragma unroll
                for (int j = 0; j < 8; ++j) ss += (ov[j].x * ov[j].x + ov[j].y * ov[j].y) + (ov[j].z * ov[j].z + ov[j].w * ov[j].w);
                const float ro = rsqrtf(wave_sum(ss) * (1.f / D) + EPS);
#pragma unroll
                for (int j = 0; j < 8; ++j) { xv[j] = xv[j] + G2[j] * (ov[j] * ro); *(f32x4*)(dst + j * 256 + lane * 4) = xv[j]; }
            }
            if (l < 4) {
                float ss = 0.f;
#pragma unroll
                for (int j = 0; j < 8; ++j) ss += (xv[j].x * xv[j].x + xv[j].y * xv[j].y) + (xv[j].z * xv[j].z + xv[j].w * xv[j].w);
                const float rx = rsqrtf(wave_sum(ss) * (1.f / D) + EPS);
#pragma unroll
                for (int j = 0; j < 8; ++j) { const int col = j * 256 + lane * 4;
                    const f32x4 hv = (xv[j] * rx) * S2[j] + SH[j];
                    u32x2 o; o.x = cvt_pk_bf16(hv.x, hv.y); o.y = cvt_pk_bf16(hv.z, hv.w);
                    *(u32x2*)(hx + (size_t)r * D + col) = o; }
            }
        }
    }
}

__device__ __forceinline__ void mlp_phase(const Args& a, unsigned char* ws, const int bid, int l, LAS unsigned char* lds, int tid, int wave, int lane) {
    bf16_t* z = (bf16_t*)(ws + WS_Z);
    const bf16_t* wsb = (const bf16_t*)(ws + WS_WSB) + (size_t)l * 16 * 16384;
    const float* rvs = (const float*)(ws + WS_RVS); float* ybs = (float*)(ws + WS_YBS);
    const float* g_v = INP(15) + l * 2048; const float* b_s = INP(17) + l * 16 * 128;
    LAS unsigned char* L_W = lds; LAS unsigned char* L_V = lds + 34816;
    const int fr = lane & 15, fq = lane >> 4, wr = wave >> 1, wc = wave & 1;
    const int G = gridDim.x;
    u32x4 tw[4], tv[4]; float trk[4]; f32x4 tg0, tg1;
#define MLP_ISSUE(it) do { const int _gc = (it) >> 4, _g = (it) & 15; \
        _Pragma("unroll") for (int i = 0; i < 4; ++i) { const int p = tid + i * 512, r = p >> 4, cp = p & 15; \
            tw[i] = *(const u32x4*)(wsb + (size_t)_g * 16384 + r * 128 + cp * 8); \
            tv[i] = *(const u32x4*)(z + (size_t)(_gc * 128 + r) * ZW + ZC_V + _g * 128 + cp * 8); \
            trk[i] = rvs[_gc * 128 + r]; } \
        tg0 = *(const f32x4*)(g_v + _g * 128 + (tid & 15) * 8); tg1 = *(const f32x4*)(g_v + _g * 128 + (tid & 15) * 8 + 4); } while (0)
    if (bid < NCH * 16) MLP_ISSUE(bid);
#pragma unroll 1
    for (int it = bid; it < NCH * 16; it += G) {
        const int gc = it >> 4, g = it & 15, row0 = gc * 128;
#pragma unroll
        for (int i = 0; i < 4; ++i) { const int p = tid + i * 512, r = p >> 4, cp = p & 15;
            *(LAS u32x4*)(L_W + r * 272 + cp * 16) = tw[i];
            float f[8]; unpack8(tv[i], f); const float rk = rsqrtf(trk[i] * (1.f / 2048.f) + EPS);
            const f32x4 g0 = tg0, g1 = tg1;
            float o[8] = {f[0] * rk * g0.x, f[1] * rk * g0.y, f[2] * rk * g0.z, f[3] * rk * g0.w, f[4] * rk * g1.x, f[5] * rk * g1.y, f[6] * rk * g1.z, f[7] * rk * g1.w};
            *(LAS u32x4*)(L_V + offb(r, cp)) = pack8(o); }
        u32x4 pu[2][2]; float pbias[2];
#pragma unroll
        for (int i = 0; i < 2; ++i) { const int q = (2 * wr + i) * 16 + fr; const bf16_t* zr = z + (size_t)(row0 + q) * ZW; pbias[i] = b_s[g * 128 + q];
#pragma unroll
            for (int m = 0; m < 2; ++m) { const int d0 = g * 128 + 32 * (2 * wc + m) + 8 * fq; pu[i][m] = *(const u32x4*)(zr + ZC_U + d0); } }
        LDS_BARRIER();
        if (it + G < NCH * 16) MLP_ISSUE(it + G);
        f32x4 acc[2][4];
#pragma unroll
        for (int i = 0; i < 2; ++i)
#pragma unroll
            for (int j = 0; j < 4; ++j) acc[i][j] = (f32x4){0.f, 0.f, 0.f, 0.f};
#pragma unroll
        for (int s = 0; s < 4; ++s) { bf16x8 wf[2], vf[4];
#pragma unroll
            for (int i = 0; i < 2; ++i) wf[i] = *(const LAS bf16x8*)(L_W + ((2 * wr + i) * 16 + fr) * 272 + s * 64 + fq * 16);
#pragma unroll
            for (int j = 0; j < 4; ++j) vf[j] = ldfrag_tr_bp(L_V, 32 * s, 4 * wc + j, lane);
            __builtin_amdgcn_sched_barrier(0);
#pragma unroll
            for (int i = 0; i < 2; ++i)
#pragma unroll
                for (int j = 0; j < 4; ++j) acc[i][j] = MFMA16(vf[j], wf[i], acc[i][j]);
            __builtin_amdgcn_sched_barrier(0); }
#pragma unroll
        for (int i = 0; i < 2; ++i) { const int q = (2 * wr + i) * 16 + fr; const float bias = pbias[i];
            bf16_t* zr = z + (size_t)(row0 + q) * ZW; float ss = 0.f;
#pragma unroll
            for (int m = 0; m < 2; ++m) { const int d0 = g * 128 + 32 * (2 * wc + m) + 8 * fq;
                float uf[8]; unpack8(pu[i][m], uf);
                float o[8];
#pragma unroll
                for (int r = 0; r < 4; ++r) { o[r] = uf[r] * (acc[i][2 * m][r] + bias); o[4 + r] = uf[4 + r] * (acc[i][2 * m + 1][r] + bias); }
#pragma unroll
                for (int e = 0; e < 8; ++e) ss += o[e] * o[e];
                *(u32x4*)(zr + ZC_U + d0) = pack8(o); }
            ss += __shfl_xor(ss, 16); ss += __shfl_xor(ss, 32);
            if (fq == 0) unsafeAtomicAdd(ybs + row0 + q, ss); }
        LDS_BARRIER();
    }
#undef MLP_ISSUE
}

__device__ __forceinline__ void conv_stream(const Args& a, unsigned char* ws, const int bid, int l, int tid) {
    const bf16_t* z = (const bf16_t*)(ws + WS_Z); bf16_t* xbc = (bf16_t*)(ws + WS_XBC);
    const int c0 = tid * 8;
    const float* cw = INP(9) + (size_t)l * 5 * 4096 + c0; const float* cbias = INP(10) + l * 4096 + c0;
    float w[5][8], bias[8];
#pragma unroll
    for (int k = 0; k < 5; ++k) { const f32x4 w0 = *(const f32x4*)(cw + k * 4096), w1 = *(const f32x4*)(cw + k * 4096 + 4);
        w[k][0] = w0.x; w[k][1] = w0.y; w[k][2] = w0.z; w[k][3] = w0.w; w[k][4] = w1.x; w[k][5] = w1.y; w[k][6] = w1.z; w[k][7] = w1.w; }
    { const f32x4 b0 = *(const f32x4*)cbias, b1 = *(const f32x4*)(cbias + 4); bias[0] = b0.x; bias[1] = b0.y; bias[2] = b0.z; bias[3] = b0.w; bias[4] = b1.x; bias[5] = b1.y; bias[6] = b1.z; bias[7] = b1.w; }
    for (int tg = bid; tg < T / 8; tg += gridDim.x) {
        const int tb = tg * 8;
        bool lo_ok, hi_ok;
        if (tb < TCTX) { lo_ok = (tb & 255) != 0; hi_ok = ((tb + 8) & 255) != 0; }
        else { lo_ok = ((tb - TCTX) & 63) != 0; hi_ok = ((tb + 8 - TCTX) & 63) != 0; }
        u32x4 rows[12];
#pragma unroll
        for (int j = 0; j < 12; ++j) { const bool ok = (j >= 2 && j < 10) || (j < 2 && lo_ok) || (j >= 10 && hi_ok);
            rows[j] = ok ? *(const u32x4*)(z + (size_t)(tb - 2 + j) * ZW + c0) : (u32x4){0u, 0u, 0u, 0u}; }
#pragma unroll
        for (int e = 0; e < 8; ++e) { float acc[8];
#pragma unroll
            for (int c = 0; c < 8; ++c) acc[c] = bias[c];
#pragma unroll
            for (int k = 0; k < 5; ++k) { float f[8]; unpack8(rows[e + k], f);
#pragma unroll
                for (int c = 0; c < 8; ++c) acc[c] += w[k][c] * f[c]; }
#pragma unroll
            for (int c = 0; c < 8; ++c) acc[c] = silu_f(acc[c]);
            *(u32x4*)(xbc + (size_t)(tb + e) * 4096 + c0) = pack8(acc); }
    }
}

__device__ __forceinline__ void phase_C0(const Args& a, unsigned char* ws, const int bid, int l, LAS unsigned char* lds, int tid, int wave, int lane) {
    const int G = gridDim.x;
    { const bf16_t* z = (const bf16_t*)(ws + WS_Z); float* DT = (float*)(ws + WS_DT); const float* dtb = INP(11) + l * 64;
      for (int idx = bid * 512 + tid; idx < T * 64; idx += G * 512) { const int t = idx >> 6, j = idx & 63;
          const float xr = bf1(z[(size_t)t * ZW + ZC_DT + j]) + dtb[j];
          const float e = __expf(-fabsf(xr)), u = 1.f + e;
          const float l1p = (u == 1.f) ? e : __logf(u) * e * __builtin_amdgcn_rcpf(u - 1.f);
          DT[idx] = fmaxf(xr, 0.f) + l1p; } }
    mlp_phase(a, ws, bid, l, lds, tid, wave, lane);
    conv_stream(a, ws, bid, l, tid);
#ifdef CONV_REP
    conv_stream(a, ws, bid, l, tid);
#endif
}

__device__ __forceinline__ void phase_C1(const Args& a, unsigned char* ws, const int bid, int l, LAS unsigned char* lds, int tid, int wave, int lane) {
    bf16_t* z = (bf16_t*)(ws + WS_Z);
    const bf16_t* xbc = (const bf16_t*)(ws + WS_XBC);
    const float* DT = (const float*)(ws + WS_DT);
    LAS unsigned char* L_C = lds; LAS unsigned char* L_B = lds + 34816; LAS unsigned char* L_M = lds + 69632; LAS unsigned char* L_X = lds + 104448; LAS unsigned char* L_H = lds + 122880;
    LAS float* cs = (LAS float*)(lds + 140288); LAS float* dtv = cs + 128; LAS float* wgt = cs + 256; LAS float* ecs = cs + 384; LAS float* f2dt = cs + 512; LAS float* refarr = cs + 640; LAS float* totp = cs + 656;
    const int fr = lane & 15, fq = lane >> 4, wr = wave >> 1, wc = wave & 1;
    const int qt = wave < 4 ? wave : 11 - wave;
    const int rb = fr * 272 + fq * 16;
    const int trB = (8 * fq + (fr >> 2)) * 272 + 8 * (lane & 3);
    const int trX = (8 * fq + (fr >> 2)) * 144 + 8 * (lane & 3);
    const int trXp = (8 * fq + (fr >> 2)) * 144 + 16 * (lane & 3);
    const int rbH = (8 * (fr >> 2) + (fr & 3)) * 272 + fq * 16;
    const unsigned offCB = (unsigned)(tid >> 4) * 4096u + (unsigned)(tid & 15) * 8u, offX = (unsigned)(tid >> 3) * 4096u + (unsigned)(tid & 7) * 8u;
    const int wCB = (tid >> 4) * 272 + (tid & 15) * 16, wX = (tid >> 3) * 144 + (tid & 7) * 16;
#define TRB(base, krow0, col0, t) __builtin_amdgcn_ds_read_tr16_b64_v4i16((LAS s16x4*)((base) + trB + ((krow0) + 4 * (t)) * 272 + (col0) * 2))
#define TRX(base, krow0, col0, t) __builtin_amdgcn_ds_read_tr16_b64_v4i16((LAS s16x4*)((base) + trX + ((krow0) + 4 * (t)) * 144 + (col0) * 2))
    for (int item = bid; item < 256; item += gridDim.x) {
        const int combo = (item & 7) * 8 + (item >> 5), hq = (item >> 3) & 3;
        const int b = combo >> 4, g = (combo >> 1) & 7, dir = combo & 1, h = 4 * g + hq;
        const float Acoef = -__expf(INP(12)[l * 64 + dir * 32 + h]);
        const float dskip = INP(13)[l * 32 + h];
        f32x4 Hacc[4];
#pragma unroll
        for (int j = 0; j < 4; ++j) Hacc[j] = (f32x4){0.f, 0.f, 0.f, 0.f};
        for (int i = tid; i < 17408 / 4; i += 512) ((LAS unsigned*)L_H)[i] = 0u;
        u32x4 pc[4], pb[4], px[2]; float pd0 = 0.f, pd1 = 0.f;
#define SSD_GC(step) ((dir == 0) ? ((step) < 2 ? 2 * b + (step) : 8 + b * 64 + ((step) - 2)) : ((step) < 2 ? 2 * b + (1 - (step)) : 8 + b * 64 + (65 - (step))))
#define SSD_ISSUE(step) do { const int _r0 = SSD_GC(step) * 128; const bf16_t* _cb = xbc + (size_t)_r0 * 4096 + 2048 + g * 128; const bf16_t* _xb = xbc + (size_t)_r0 * 4096 + h * 64; \
            _Pragma("unroll") for (int i = 0; i < 4; ++i) { pc[i] = *(const u32x4*)(_cb + 1024 + (size_t)i * 32 * 4096 + offCB); pb[i] = *(const u32x4*)(_cb + (size_t)i * 32 * 4096 + offCB); } \
            _Pragma("unroll") for (int i = 0; i < 2; ++i) px[i] = *(const u32x4*)(_xb + (size_t)i * 64 * 4096 + offX); \
            if (wave == 0) { pd0 = DT[(size_t)(_r0 + 2 * lane) * 64 + dir * 32 + h]; pd1 = DT[(size_t)(_r0 + 2 * lane + 1) * 64 + dir * 32 + h]; } } while (0)
        SSD_ISSUE(0);
#pragma unroll 1
        for (int step = 0; step < 66; ++step) {
            const int row0 = SSD_GC(step) * 128;
#pragma unroll
            for (int i = 0; i < 4; ++i) { *(LAS u32x4*)(L_C + wCB + i * 32 * 272) = pc[i]; *(LAS u32x4*)(L_B + wCB + i * 32 * 272) = pb[i]; }
#pragma unroll
            for (int i = 0; i < 2; ++i) *(LAS u32x4*)(L_X + wX + i * 64 * 144) = px[i];
            if (wave == 0) {
                const int t0 = 2 * lane;
                const float d0 = pd0, d1 = pd1;
                const float a0 = d0 * Acoef, a1 = d1 * Acoef, pair = a0 + a1; const float incl = wave_incl_scan(pair);
                const float tot = __builtin_bit_cast(float, __builtin_amdgcn_readlane(__builtin_bit_cast(int, incl), 63)), excl = incl - pair;
                float c0v, c1v, ref;
                if (dir == 0) { c0v = excl + a0; c1v = incl; ref = __shfl(c1v, (lane & ~7) + 7); }
                else { c0v = tot - excl; c1v = tot - incl + a1; ref = __shfl(c0v, lane & ~7); }
                cs[t0] = c0v; cs[t0 + 1] = c1v; dtv[t0] = d0; dtv[t0 + 1] = d1;
                wgt[t0] = d0 * __expf(tot - c0v); wgt[t0 + 1] = d1 * __expf(tot - c1v);
                ecs[t0] = __expf(c0v); ecs[t0 + 1] = __expf(c1v);
                f2dt[t0] = d0 * __expf(ref - c0v); f2dt[t0 + 1] = d1 * __expf(ref - c1v);
                if ((lane & 7) == 0) refarr[lane >> 3] = ref;
                if (lane == 0) totp[0] = tot;
            }
            LDS_BARRIER();
            if (step + 1 < 66) SSD_ISSUE(step + 1);
            f32x4 accA[8], accC[4];
#pragma unroll
            for (int j = 0; j < 8; ++j) accA[j] = (f32x4){0.f, 0.f, 0.f, 0.f};
#pragma unroll
            for (int j = 0; j < 4; ++j) accC[j] = (f32x4){0.f, 0.f, 0.f, 0.f};
            {
                bf16x8 cqv[2], bq[2][4], hq[2][2];
#define SSD_LDH(buf, h_) do { const int _s = (h_) >> 1, _hf = (h_) & 1; if (_hf == 0) cqv[_s & 1] = *(const LAS bf16x8*)(L_C + qt * (16 * 272) + rb + _s * 64); \
                    _Pragma("unroll") for (int k = 0; k < 4; ++k) bq[buf][k] = *(const LAS bf16x8*)(L_B + (4 * _hf + k) * (16 * 272) + rb + _s * 64); \
                    _Pragma("unroll") for (int p = 0; p < 2; ++p) hq[buf][p] = *(const LAS bf16x8*)(L_H + (32 * _hf + 4 * p) * 272 + rbH + _s * 64); } while (0)
                SSD_LDH(0, 0);
#pragma unroll
                for (int h2 = 0; h2 < 8; ++h2) { const int cb = h2 & 1, s_ = h2 >> 1, hf_ = h2 & 1;
                    if (h2 < 7) SSD_LDH(cb ^ 1, h2 + 1);
                    __builtin_amdgcn_sched_barrier(0);
#pragma unroll
                    for (int k = 0; k < 4; ++k) accA[4 * hf_ + k] = MFMA16(bq[cb][k], cqv[s_ & 1], accA[4 * hf_ + k]);
#pragma unroll
                    for (int p = 0; p < 2; ++p) accC[2 * hf_ + p] = MFMA16(hq[cb][p], cqv[s_ & 1], accC[2 * hf_ + p]);
                    __builtin_amdgcn_sched_barrier(0); }
#undef SSD_LDH
            }
            { const float etot = __expf(totp[0]);
#pragma unroll
              for (int j = 0; j < 4; ++j) Hacc[j] = Hacc[j] * etot;
#pragma unroll
              for (int s = 0; s < 4; ++s) { const s16x4 xlo = TRX(L_X, 32 * s, 16 * wr, 0), xhi = TRX(L_X, 32 * s, 16 * wr, 1);
                  const f32x4 w0 = *(const LAS f32x4*)(wgt + s * 32 + fq * 8), w1 = *(const LAS f32x4*)(wgt + s * 32 + fq * 8 + 4);
                  s16x4 blo[4], bhi[4];
#pragma unroll
                  for (int j = 0; j < 4; ++j) { blo[j] = TRB(L_B, 32 * s, 16 * (4 * wc + j), 0); bhi[j] = TRB(L_B, 32 * s, 16 * (4 * wc + j), 1); }
                  __builtin_amdgcn_sched_barrier(0);
                  const u32x2 xl = __builtin_bit_cast(u32x2, xlo), xh = __builtin_bit_cast(u32x2, xhi);
                  u32x4 xs; xs.x = cvt_pk_bf16(bflo(xl.x) * w0.x, bfhi(xl.x) * w0.y); xs.y = cvt_pk_bf16(bflo(xl.y) * w0.z, bfhi(xl.y) * w0.w);
                  xs.z = cvt_pk_bf16(bflo(xh.x) * w1.x, bfhi(xh.x) * w1.y); xs.w = cvt_pk_bf16(bflo(xh.y) * w1.z, bfhi(xh.y) * w1.w);
                  const bf16x8 xq = __builtin_bit_cast(bf16x8, xs);
#pragma unroll
                  for (int j = 0; j < 4; ++j) { const bf16x8 bt = (bf16x8){blo[j].x, blo[j].y, blo[j].z, blo[j].w, bhi[j].x, bhi[j].y, bhi[j].z, bhi[j].w};
                      Hacc[j] = MFMA16(bt, xq, Hacc[j]); }
                  __builtin_amdgcn_sched_barrier(0); } }
            { const int q = qt * 16 + fr; const float csq = cs[q], eq = ecs[q];
              f32x4 gd = accA[0];
#pragma unroll
              for (int kt = 1; kt < 8; ++kt) { const bool is = (kt == qt); gd.x = is ? accA[kt].x : gd.x; gd.y = is ? accA[kt].y : gd.y; gd.z = is ? accA[kt].z : gd.z; gd.w = is ? accA[kt].w : gd.w; }
#pragma unroll
              for (int kt = 0; kt < 8; ++kt) { const int k0 = kt * 16 + fq * 4;
                  const bool kept = dir == 0 ? (kt < qt) : (kt > qt);
                  const float f1 = __expf(csq - refarr[kt]); const f32x4 f2 = *(const LAS f32x4*)(f2dt + k0);
                  float m[4];
#pragma unroll
                  for (int r = 0; r < 4; ++r) m[r] = kept ? accA[kt][r] * f1 * f2[r] : 0.f;
                  u32x2 o; o.x = cvt_pk_bf16(m[0], m[1]); o.y = cvt_pk_bf16(m[2], m[3]);
                  *(LAS u32x2*)(L_M + q * 272 + k0 * 2) = o; }
              { const int k0 = qt * 16 + fq * 4; const f32x4 ck = *(const LAS f32x4*)(cs + k0), dk = *(const LAS f32x4*)(dtv + k0); float m[4];
#pragma unroll
                for (int r = 0; r < 4; ++r) { const int kk = k0 + r; const bool keep = dir == 0 ? (kk <= q) : (kk >= q); m[r] = keep ? gd[r] * __expf(csq - ck[r]) * dk[r] : 0.f; }
                u32x2 o; o.x = cvt_pk_bf16(m[0], m[1]); o.y = cvt_pk_bf16(m[2], m[3]);
                *(LAS u32x2*)(L_M + q * 272 + k0 * 2) = o; }
              f32x4 accB[4];
#pragma unroll
              for (int j = 0; j < 4; ++j) accB[j] = (f32x4){0.f, 0.f, 0.f, 0.f};
#pragma unroll
              for (int s = 0; s < 4; ++s) { const bf16x8 mq = *(const LAS bf16x8*)(L_M + qt * (16 * 272) + rb + s * 64);
                  s16x4 xlo[4], xhi[4];
#pragma unroll
                  for (int pt = 0; pt < 4; ++pt) { xlo[pt] = __builtin_amdgcn_ds_read_tr16_b64_v4i16((LAS s16x4*)(L_X + trXp + (32 * s) * 144 + (32 * (pt >> 1) + 4 * (pt & 1)) * 2));
                      xhi[pt] = __builtin_amdgcn_ds_read_tr16_b64_v4i16((LAS s16x4*)(L_X + trXp + (32 * s + 4) * 144 + (32 * (pt >> 1) + 4 * (pt & 1)) * 2)); }
                  __builtin_amdgcn_sched_barrier(0);
#pragma unroll
                  for (int pt = 0; pt < 4; ++pt) { const bf16x8 xf = (bf16x8){xlo[pt].x, xlo[pt].y, xlo[pt].z, xlo[pt].w, xhi[pt].x, xhi[pt].y, xhi[pt].z, xhi[pt].w}; accB[pt] = MFMA16(xf, mq, accB[pt]); }
                  __builtin_amdgcn_sched_barrier(0); }
              bf16_t* yrow = z + (size_t)(row0 + q) * ZW + dir * 2048 + h * 64 + 8 * fq;
#pragma unroll
              for (int m = 0; m < 2; ++m) { float y[8];
#pragma unroll
                  for (int r = 0; r < 4; ++r) { y[r] = accB[2 * m][r] + eq * accC[2 * m][r]; y[4 + r] = accB[2 * m + 1][r] + eq * accC[2 * m + 1][r]; }
                  if (dir == 0) { const u32x4 xv = *(const LAS u32x4*)(L_X + q * 144 + (32 * m + 8 * fq) * 2); float xf8[8]; unpack8(xv, xf8);
#pragma unroll
                      for (int e = 0; e < 8; ++e) y[e] += dskip * xf8[e]; }
                  *(u32x4*)(yrow + 32 * m) = pack8(y); } }
            LDS_BARRIER();
#pragma unroll
            for (int j = 0; j < 4; ++j) { u32x2 o; o.x = cvt_pk_bf16(Hacc[j][0], Hacc[j][1]); o.y = cvt_pk_bf16(Hacc[j][2], Hacc[j][3]);
                *(LAS u32x2*)(L_H + (wr * 16 + fr) * 272 + ((4 * wc + j) * 16 + fq * 4) * 2) = o; }
        }
        __syncthreads();
#undef SSD_GC
#undef SSD_ISSUE
    }
#undef TRB
#undef TRX
}

__device__ __forceinline__ void phase_C2(const Args& a, unsigned char* ws, const int bid, int l, int wave, int lane) {
    bf16_t* z = (bf16_t*)(ws + WS_Z);
    const float* g_ssd = INP(14) + l * 2048; const float* g_mlp = INP(18) + l * 2048;
    const int gw = bid * 8 + wave, NGW = gridDim.x * 8;
    f32x4 gs[8];
#pragma unroll
    for (int j = 0; j < 4; ++j) { gs[2 * j] = *(const f32x4*)(g_ssd + j * 512 + lane * 8); gs[2 * j + 1] = *(const f32x4*)(g_ssd + j * 512 + lane * 8 + 4); }
    for (int r = gw + (l == 3 ? TCTX : 0); r < T; r += NGW) {
        bf16_t* zr = z + (size_t)r * ZW;
        const float ybr = ((const float*)(ws + WS_YBS))[r];
        float yv[32]; float ss = 0.f;
#pragma unroll
        for (int j = 0; j < 4; ++j) { const int col = j * 512 + lane * 8;
            const u32x4 yf = *(const u32x4*)(zr + col), yb = *(const u32x4*)(zr + 2048 + col), zs = *(const u32x4*)(zr + ZC_ZSSD + col);
            float f0[8], f1[8], f2[8]; unpack8(yf, f0); unpack8(yb, f1); unpack8(zs, f2);
#pragma unroll
            for (int e = 0; e < 8; ++e) { const float y = (f0[e] + f1[e]) * silu_f(f2[e]); yv[j * 8 + e] = y; ss += y * y; } }
        const float ra = rsqrtf(wave_sum(ss) * (1.f / 2048.f) + EPS) * sqrtf(ybr * (1.f / 2048.f) + EPS);
#pragma unroll
        for (int j = 0; j < 4; ++j) { const int col = j * 512 + lane * 8;
            const f32x4 g0 = gs[2 * j], g1 = gs[2 * j + 1];
            float o[8] = {yv[j * 8 + 0] * ra * g0.x, yv[j * 8 + 1] * ra * g0.y, yv[j * 8 + 2] * ra * g0.z, yv[j * 8 + 3] * ra * g0.w,
                          yv[j * 8 + 4] * ra * g1.x, yv[j * 8 + 5] * ra * g1.y, yv[j * 8 + 6] * ra * g1.z, yv[j * 8 + 7] * ra * g1.w};
            *(u32x4*)(zr + ZC_ZSSD + col) = pack8(o); }
    }
}

__global__ void __launch_bounds__(512, 2) mk_fwd(Args a) {
    extern __shared__ __attribute__((aligned(16))) unsigned char lds_raw[];
    LAS unsigned char* lds = (LAS unsigned char*)lds_raw;
    cg::grid_group grid = cg::this_grid();
    { LAS unsigned* stw = (LAS unsigned*)(lds + LDS_BAR_OFF); if (threadIdx.x < 4) stw[threadIdx.x] = 0u; }
    __syncthreads();
    (void)xcd_barrier_post((unsigned*)(a.ws + WS_BAR), (volatile LAS unsigned*)(lds + LDS_BAR_OFF));
    int ph = a.ph_lo, rep = 0, nsync = 0; bool first = true;
#ifdef SYNC_PROBE
    for (int i = 0; i < 100; ++i) { XcdBarrier xb; xb.bar = (unsigned*)(a.ws + WS_BAR); xb.x = xb_xcc_id(); xb.st = (volatile LAS unsigned*)(lds + LDS_BAR_OFF); xcd_barrier(xb); }
#endif
#pragma unroll 1
    while (ph < a.ph_hi) {
        if (!first) { if (nsync == 0) grid.sync(); else { XcdBarrier xb; xb.bar = (unsigned*)(a.ws + WS_BAR); xb.x = xb_xcc_id(); xb.st = (volatile LAS unsigned*)(lds + LDS_BAR_OFF); xcd_barrier(xb); } ++nsync; }
        first = false;
        int tid = threadIdx.x; asm volatile("" : "+v"(tid));
        int bid = blockIdx.x; asm volatile("" : "+s"(bid));
        long zo = 0; asm volatile("" : "+s"(zo)); unsigned char* ws = a.ws + zo;
        const int wave = __builtin_amdgcn_readfirstlane(tid >> 6), lane = tid & 63;
        const int l = (ph - 1) / 6, sub = (ph - 1) % 6;
        if (ph == 0) phase_prologue(a, ws, bid, lds, tid, wave, lane);
        else if (sub == 0) phase_A(a, ws, bid, l, wave, lane);
        else if (sub == 1 || sub == 5) {
            pg8::Gemm g; void* cout; int ldc, mode;
            int tail = 0; g.A2 = nullptr; g.P2 = nullptr; const float* rbs = nullptr; const float* rbs_tail = nullptr;
            if (sub == 1) { g.A = (const bf16_t*)(ws + WS_HX); g.Bt = (const bf16_t*)(ws + WS_WIN) + (size_t)l * ZW * 2048; g.M = T; g.N = ZW; g.K = 2048; g.lda = 2048; cout = ws + WS_Z; ldc = ZW; mode = 0; }
            else { const int r0 = TCTX; rbs = (const float*)(ws + WS_YBS) + r0; rbs_tail = (const float*)(ws + WS_YBS);
                if (l < 3) { tail = 1; g.A2 = (const bf16_t*)(ws + WS_Z) + 4096; g.P2 = (float*)(ws + WS_XBC); }
                g.A = (const bf16_t*)(ws + WS_Z) + (size_t)r0 * ZW + 4096; g.Bt = (const bf16_t*)(ws + WS_WOUT) + (size_t)l * 2048 * 4096; g.M = T - r0; g.N = 2048; g.K = 4096; g.lda = ZW;
                cout = (bf16_t*)(ws + WS_Z) + (size_t)r0 * ZW; ldc = ZW; mode = 0; }
            pg8::StaticOrder S; S.init(g.M, g.N, (int)gridDim.x, bid, tail);
            pg8::gemm_phase(tid, lds, g, S, mode, cout, ldc, sub == 1 ? (float*)(ws + WS_RVS) : (float*)nullptr, rbs, rbs_tail);
            if (sub == 1 && l < 3) {
                const int nlong = (ZW / 256) * (T / 256) - ((ZW / 256) * (T / 256) / (int)gridDim.x) * (int)gridDim.x, G_ = (int)gridDim.x;
                if (nlong > 0 && nlong < G_) { if (bid >= nlong) convert_layer_weights(a, ws, l + 1, (bid - nlong) * 8 + wave, (G_ - nlong) * 8, lds, wave, lane); }
                else convert_layer_weights(a, ws, l + 1, bid * 8 + wave, G_ * 8, lds, wave, lane);
            }
        }
        else if (sub == 2) phase_C0(a, ws, bid, l, lds, tid, wave, lane);
        else if (sub == 3) phase_C1(a, ws, bid, l, lds, tid, wave, lane);
        else phase_C2(a, ws, bid, l, wave, lane);
        const int reps = ((ph > 0 && ((REP_MASK >> sub) & 1)) || (ph == 0 && (REP_MASK & 64)) || (ph > 0 && sub == 0 && l <= 1 && (REP_MASK & 128))) ? 2 : 1;
        if (++rep >= reps) { rep = 0; ++ph; }
    }
}

extern "C" void kernel_launch(void* const* d_in, const int* in_sizes, int n_in, void* d_out, int out_size, void* d_ws, size_t ws_size, hipStream_t stream) {
    static int grid = 0;
    if (grid == 0) {
        if (n_in != 20 || ws_size < WS_END) { fprintf(stderr, "kernel_launch: need 20 inputs and %zu bytes of workspace (got %d, %zu)\n", (size_t)WS_END, n_in, ws_size); grid = -1; return; }
        int dev = 0, cus = 0, per_cu = 0;
        hipGetDevice(&dev);
        hipDeviceGetAttribute(&cus, hipDeviceAttributeMultiprocessorCount, dev);
        hipFuncSetAttribute((const void*)mk_fwd, hipFuncAttributeMaxDynamicSharedMemorySize, LDS_BYTES);
        if (hipOccupancyMaxActiveBlocksPerMultiprocessor(&per_cu, (const void*)mk_fwd, 512, LDS_BYTES) != hipSuccess || per_cu < 1) per_cu = 1;
        (void)hipGetLastError();
        grid = cus * per_cu;
    }
    if (grid < 0) return;
    Args a{};
    for (int i = 0; i < 20; ++i) a.in[i] = (const float*)d_in[i];
    a.out = (float*)d_out; a.ws = (unsigned char*)d_ws; a.ph_lo = 0; a.ph_hi = 26;
    if (hipMemsetAsync((char*)d_ws + WS_BAR, 0, XCD_BAR_WORDS * sizeof(unsigned), stream) != hipSuccess) { fprintf(stderr, "kernel_launch: memset of the barrier words failed\n"); return; }
    void* args[] = {&a};
    hipError_t e = hipLaunchCooperativeKernel((const void*)mk_fwd, dim3(grid), dim3(512), args, LDS_BYTES, stream);
    if (e != hipSuccess) fprintf(stderr, "cooperative launch failed: %s (grid %d)\n", hipGetErrorString(e), grid);
}
```

```cpp
#include <hip/hip_runtime.h>
#include <hip/hip_cooperative_groups.h>
#include <cstdio>
#include <cstdint>
namespace cg = cooperative_groups;

#define LAS __attribute__((address_space(3)))
typedef unsigned short bf16_t;
typedef short bf16x8 __attribute__((ext_vector_type(8)));
typedef float f32x4 __attribute__((ext_vector_type(4)));
typedef float f32x2 __attribute__((ext_vector_type(2)));
typedef unsigned u32x4 __attribute__((ext_vector_type(4)));
typedef unsigned u32x2 __attribute__((ext_vector_type(2)));

constexpr int D = 2048, NB = 4, SEQ = 8192, DEPTH = 4, CTXL = 256;
constexpr int TCTX = NB * CTXL;
constexpr int T = TCTX + NB * SEQ;
constexpr int NCH = T / 128;
constexpr int ZW = 12544;
constexpr int ZC_ZSSD = 4096, ZC_U = 6144, ZC_V = 8192, ZC_ZMLP = 10240, ZC_DT = 12288;
constexpr int INW = 12352;
constexpr float EPS = 1e-6f;
constexpr int LDS_BAR_OFF = 161280;
constexpr int LDS_BYTES = 161296;
#ifndef REP_MASK
#define REP_MASK 0
#endif

constexpr size_t WS_BAR = 0;
constexpr size_t WS_MOD = 16384;
constexpr size_t WS_WSB = WS_MOD + 491520;
constexpr size_t WS_RVS = WS_WSB + 2097152;
constexpr size_t WS_YBS = WS_RVS + (size_t)T * 4;
constexpr size_t WS_DT = WS_YBS + (size_t)T * 4;
constexpr size_t WS_CTX = WS_DT + (size_t)T * 64 * 4;
constexpr size_t WS_WIN = WS_CTX + (size_t)TCTX * D * 4;
constexpr size_t WS_WOUT = WS_WIN + (size_t)4 * ZW * D * 2;
constexpr size_t WS_HX = WS_WOUT + (size_t)4 * 2048 * 4096 * 2;
constexpr size_t WS_Z = WS_HX + (size_t)T * D * 2;
constexpr size_t WS_XBC = WS_Z + (size_t)T * ZW * 2;
constexpr size_t WS_END = WS_XBC + (size_t)T * 4096 * 2;

struct Args { const float* in[20]; float* out; unsigned char* ws; int ph_lo, ph_hi; };

__device__ __forceinline__ unsigned cvt_pk_bf16(float lo, float hi) { unsigned r; asm volatile("v_cvt_pk_bf16_f32 %0, %1, %2" : "=v"(r) : "v"(lo), "v"(hi)); return r; }
__device__ __forceinline__ float bflo(unsigned u) { return __builtin_bit_cast(float, u << 16); }
__device__ __forceinline__ float bfhi(unsigned u) { return __builtin_bit_cast(float, u & 0xffff0000u); }
__device__ __forceinline__ float bf1(bf16_t h) { return __builtin_bit_cast(float, ((unsigned)h) << 16); }
template <int CTRL, int ROWMASK> __device__ __forceinline__ float dpp_get0(float v) { return __builtin_bit_cast(float, __builtin_amdgcn_update_dpp(0, __builtin_bit_cast(int, v), CTRL, ROWMASK, 0xf, true)); }
__device__ __forceinline__ float wave_incl_scan(float v) {
    v += dpp_get0<0x111, 0xf>(v); v += dpp_get0<0x112, 0xf>(v); v += dpp_get0<0x114, 0xf>(v); v += dpp_get0<0x118, 0xf>(v);
    v += dpp_get0<0x142, 0xa>(v);
    v += dpp_get0<0x143, 0xc>(v);
    return v;
}
__device__ __forceinline__ float wave_sum(float v) {
    return __builtin_bit_cast(float, __builtin_amdgcn_readlane(__builtin_bit_cast(int, wave_incl_scan(v)), 63));
}
__device__ __forceinline__ float silu_f(float x) { return x * __builtin_amdgcn_rcpf(1.f + __expf(-x)); }
__device__ __forceinline__ void unpack8(const u32x4 v, float* f) {
    f[0] = bflo(v.x); f[1] = bfhi(v.x); f[2] = bflo(v.y); f[3] = bfhi(v.y); f[4] = bflo(v.z); f[5] = bfhi(v.z); f[6] = bflo(v.w); f[7] = bfhi(v.w);
}
__device__ __forceinline__ u32x4 pack8(const float* f) {
    u32x4 w; w.x = cvt_pk_bf16(f[0], f[1]); w.y = cvt_pk_bf16(f[2], f[3]); w.z = cvt_pk_bf16(f[4], f[5]); w.w = cvt_pk_bf16(f[6], f[7]); return w;
}
__device__ __forceinline__ const float* inp_(const float* p) { long zo = 0; asm volatile("" : "+s"(zo)); return p + zo; }
#define INP(k) inp_(a.in[k])
typedef short s16x4 __attribute__((ext_vector_type(4)));
__device__ __forceinline__ bf16x8 ldfrag_tr(LAS const unsigned char* base, const int pitch, const int krow0, const int col0, const int lane) {
    const int g = lane >> 4, q = (lane & 15) >> 2, p = lane & 3;
    LAS const unsigned char* a0 = base + (krow0 + 8 * g + q) * pitch + (col0 + 4 * p) * 2;
    const s16x4 lo = __builtin_amdgcn_ds_read_tr16_b64_v4i16((LAS s16x4*)a0);
    const s16x4 hi = __builtin_amdgcn_ds_read_tr16_b64_v4i16((LAS s16x4*)(a0 + 4 * pitch));
    return (bf16x8){lo.x, lo.y, lo.z, lo.w, hi.x, hi.y, hi.z, hi.w};
}
__device__ __forceinline__ int offb(const int row, const int ch) { return 256 * row + 16 * (ch ^ (((row & 3) << 2) | ((row >> 2) & 3))); }
__device__ __forceinline__ int offx(const int row, const int ch) { return 128 * row + 16 * (ch ^ ((((row >> 1) & 1) << 1) | (((row >> 3) & 1) << 2))); }
__device__ __forceinline__ bf16x8 ldfrag_tr_b(LAS const unsigned char* base, const int krow0, const int c, const int lane) {
    const int g = lane >> 4, q = (lane & 15) >> 2, p = lane & 3, row = krow0 + 8 * g + q;
    const s16x4 lo = __builtin_amdgcn_ds_read_tr16_b64_v4i16((LAS s16x4*)(base + offb(row, 2 * c + (p >> 1)) + 8 * (p & 1)));
    const s16x4 hi = __builtin_amdgcn_ds_read_tr16_b64_v4i16((LAS s16x4*)(base + offb(row + 4, 2 * c + (p >> 1)) + 8 * (p & 1)));
    return (bf16x8){lo.x, lo.y, lo.z, lo.w, hi.x, hi.y, hi.z, hi.w};
}
__device__ __forceinline__ bf16x8 ldfrag_tr_bp(LAS const unsigned char* base, const int krow0, const int c, const int lane) {
    const int g = lane >> 4, q = (lane & 15) >> 2, p = lane & 3, row = krow0 + 8 * g + q, ch = 4 * (c >> 1) + p, b8 = 8 * (c & 1);
    const s16x4 lo = __builtin_amdgcn_ds_read_tr16_b64_v4i16((LAS s16x4*)(base + offb(row, ch) + b8));
    const s16x4 hi = __builtin_amdgcn_ds_read_tr16_b64_v4i16((LAS s16x4*)(base + offb(row + 4, ch) + b8));
    return (bf16x8){lo.x, lo.y, lo.z, lo.w, hi.x, hi.y, hi.z, hi.w};
}
__device__ __forceinline__ bf16x8 ldfrag_tr_x(LAS const unsigned char* base, const int krow0, const int c, const int lane) {
    const int g = lane >> 4, q = (lane & 15) >> 2, p = lane & 3, row = krow0 + 8 * g + q;
    LAS const unsigned char* a0 = base + offx(row, 2 * c + (p >> 1)) + 8 * (p & 1);
    const s16x4 lo = __builtin_amdgcn_ds_read_tr16_b64_v4i16((LAS s16x4*)a0);
    const s16x4 hi = __builtin_amdgcn_ds_read_tr16_b64_v4i16((LAS s16x4*)(a0 + 512));
    return (bf16x8){lo.x, lo.y, lo.z, lo.w, hi.x, hi.y, hi.z, hi.w};
}
#define LDS_BARRIER() do { asm volatile("s_waitcnt lgkmcnt(0)" ::: "memory"); __builtin_amdgcn_s_barrier(); asm volatile("" ::: "memory"); } while (0)
#define MFMA16(a, b, c) __builtin_amdgcn_mfma_f32_16x16x32_bf16((a), (b), (c), 0, 0, 0)

namespace pg8 {
constexpr int BM = 256, BK = 64, HALF = 128, HTB = HALF * BK * 2, STAGE_BYTES = 8 * HTB, NXCD = 8, WGM = 8;
__device__ __forceinline__ int lds_byte(int r, int c) { const int st = (r >> 4) * 2 + (c >> 5), rr = r & 15, cc = c & 31, ob = rr * 64 + cc * 2; return st * 1024 + (ob ^ (((ob >> 9) & 1) << 5)); }
__device__ __forceinline__ void stage_rc(int b, int& R, int& C) { const int st = b / 1024, sb = b % 1024, swz = sb ^ (((sb >> 9) & 1) << 5); R = (st >> 1) * 16 + swz / 64; C = (st & 1) * 32 + (swz % 64) / 2; }
__device__ __forceinline__ int perm32(int rho) { const int n = rho >> 4, i = rho & 15; return 8 * (i >> 2) + 4 * n + (i & 3); }
struct Unit { int pm, pn, kc; };
struct Gemm { const bf16_t* A; const bf16_t* Bt; int M, N, K, lda; const bf16_t* A2; float* P2; };
struct StaticOrder {
    int nM, nN, nwg, G, c, tail;
    __device__ void init(int M, int N, int G_, int c_, int tail_) { nM = M / BM; nN = N / BM; nwg = nM * nN; G = G_; c = c_; tail = tail_; }
    __device__ bool next(int i, Unit& u) const {
        const long L = (long)i * G + c;
        if (L >= nwg) { const long t = L - nwg; if (!tail || t >= 256) return false; u.pm = (int)(t >> 6); u.pn = (int)(t >> 3) & 7; u.kc = (int)t & 7; return true; }
        u.kc = -1;
        int wgid = (int)L; { const int q = nwg / NXCD, r = nwg % NXCD, xcd = wgid % NXCD, off = wgid / NXCD; wgid = (xcd < r ? xcd * (q + 1) : r * (q + 1) + (xcd - r) * q) + off; }
        const int nig = WGM * nN, gid = wgid / nig, fm = gid * WGM, gsz = (nM - fm) < WGM ? (nM - fm) : WGM;
        u.pm = fm + ((wgid % nig) % gsz); u.pn = (wgid % nig) / gsz; return true;
    }
};
struct EpiF32 {
    static constexpr bool PERM = false;
    float* C; int ldc;
    __device__ __forceinline__ void operator()(const f32x4 (&acc)[2][2][4][2], const Unit& u, int wr, int wc, int fr, int fq) const {
        const int row0 = u.pm * BM + wr * 64 + fr, col0 = u.pn * BM + wc * 32 + 4 * fq;
#pragma unroll
        for (int ai = 0; ai < 2; ++ai)
#pragma unroll
            for (int m = 0; m < 4; ++m) { float* rowp = C + (size_t)(row0 + ai * HALF + m * 16) * ldc + col0;
#pragma unroll
                for (int bj = 0; bj < 2; ++bj)
#pragma unroll
                    for (int n = 0; n < 2; ++n) *(f32x4*)(rowp + bj * HALF + n * 16) = acc[ai][bj][m][n]; }
    }
};
struct EpiF32Perm {
    float* C; int ldc;
    __device__ __forceinline__ void operator()(const f32x4 (&acc)[2][2][4][2], const Unit& u, int wr, int wc, int fr, int fq) const {
        const int row0 = u.pm * BM + wr * 64 + fr, col0 = u.pn * BM + wc * 32 + 8 * fq;
#pragma unroll
        for (int ai = 0; ai < 2; ++ai)
#pragma unroll
            for (int m = 0; m < 4; ++m) { float* rowp = C + (size_t)(row0 + ai * HALF + m * 16) * ldc + col0;
#pragma unroll
                for (int bj = 0; bj < 2; ++bj) { *(f32x4*)(rowp + bj * HALF) = acc[ai][bj][m][0]; *(f32x4*)(rowp + bj * HALF + 4) = acc[ai][bj][m][1]; } }
    }
};
struct EpiBf16 {
    static constexpr bool PERM = true;
    bf16_t* O; int ldc;
    __device__ __forceinline__ void operator()(const f32x4 (&acc)[2][2][4][2], const Unit& u, int wr, int wc, int fr, int fq) const {
        const int row0 = u.pm * BM + wr * 64 + fr, col0 = u.pn * BM + wc * 32 + 8 * fq;
#pragma unroll
        for (int ai = 0; ai < 2; ++ai)
#pragma unroll
            for (int m = 0; m < 4; ++m) { bf16_t* rowp = O + (size_t)(row0 + ai * HALF + m * 16) * ldc + col0;
#pragma unroll
                for (int bj = 0; bj < 2; ++bj) { const f32x4 v0 = acc[ai][bj][m][0], v1 = acc[ai][bj][m][1];
                    u32x4 w; w.x = cvt_pk_bf16(v0[0], v0[1]); w.y = cvt_pk_bf16(v0[2], v0[3]); w.z = cvt_pk_bf16(v1[0], v1[1]); w.w = cvt_pk_bf16(v1[2], v1[3]);
                    __builtin_nontemporal_store(w, (u32x4*)(rowp + bj * HALF)); } }
    }
};

__device__ __forceinline__ void gemm_phase(const int tid, LAS unsigned char* lds, const Gemm g, const StaticOrder& S, const int mode  , void* Cout, const int ldc, float* rvs, const float* rbs, const float* rbs_tail) {
    const int wid = __builtin_amdgcn_readfirstlane(tid >> 6), lane = tid & 63, wr = wid >> 2, wc = wid & 3, fr = lane & 15, fq = lane >> 4;
    const int K = g.K, nt = K / BK, lda = g.lda;
    unsigned voffA[2], voffB[2];
#pragma unroll
    for (int i = 0; i < 2; ++i) { int R, C; stage_rc(tid * 16 + i * 8192, R, C); const int Rb = (mode == 0) ? ((R & ~31) + perm32(R & 31)) : R;
        voffA[i] = (unsigned)(R * lda + C) * 2u; voffB[i] = (unsigned)(Rb * K + C) * 2u; }
    const size_t kstep = (size_t)(BK * 2);
    const size_t hstepA = (size_t)HALF * lda * 2, hstepB = (size_t)HALF * K * 2;
    const size_t tstepA = 2 * hstepA, tstepB = 2 * hstepB;
    const unsigned ldsw = (unsigned)wid * 1024u;
    const int aoff = lds_byte(wr * 64 + fr, fq * 8), boff = lds_byte(wc * 32 + fr, fq * 8);
#define PG8_SA(b, h) (((b) * 2 + (h)) * HTB)
#define PG8_SB(b, h) ((4 + (b) * 2 + (h)) * HTB)
#define PG8_STAGE(bufoff, gbase, voff) do { _Pragma("unroll") for (int _i = 0; _i < 2; ++_i) \
        __builtin_amdgcn_global_load_lds((const unsigned*)((const char*)(gbase) + (voff)[_i]), (LAS unsigned*)(lds + (bufoff) + ldsw + _i * 8192), 16, 0, 0); } while (0)
#define PG8_LDA(dst, b, h) do { _Pragma("unroll") for (int m = 0; m < 4; ++m) _Pragma("unroll") for (int k = 0; k < 2; ++k) dst[m][k] = *(const LAS bf16x8*)(lds + PG8_SA(b, h) + aoff + m * 2048 + k * 1024); } while (0)
#define PG8_LDB(dst, b, h) do { _Pragma("unroll") for (int n = 0; n < 2; ++n) _Pragma("unroll") for (int k = 0; k < 2; ++k) dst[n][k] = *(const LAS bf16x8*)(lds + PG8_SB(b, h) + boff + n * 2048 + k * 1024); } while (0)
#define PG8_MMA(ai, bj, At, Bt) do { __builtin_amdgcn_s_setprio(1); _Pragma("unroll") for (int m = 0; m < 4; ++m) _Pragma("unroll") for (int n = 0; n < 2; ++n) _Pragma("unroll") for (int k = 0; k < 2; ++k) \
        acc[ai][bj][m][n] = __builtin_amdgcn_mfma_f32_16x16x32_bf16(Bt[n][k], At[m][k], acc[ai][bj][m][n], 0, 0, 0); __builtin_amdgcn_s_setprio(0); } while (0)
#define PG8_WAIT_V(n) asm volatile("s_waitcnt vmcnt(" #n ")" ::: "memory")
#define PG8_WAIT_L(n) asm volatile("s_waitcnt lgkmcnt(" #n ")" ::: "memory")
#define PG8_BAR __builtin_amdgcn_s_barrier()
#define PG8_SCHED __builtin_amdgcn_sched_barrier(0)
    Unit cur, nxt; int ui = 0;
    if (!S.next(0, cur)) return;
    f32x4 acc[2][2][4][2];
#pragma unroll
    for (int a = 0; a < 2; ++a)
#pragma unroll
        for (int b = 0; b < 2; ++b)
#pragma unroll
            for (int m = 0; m < 4; ++m)
#pragma unroll
                for (int n = 0; n < 2; ++n) acc[a][b][m][n] = (f32x4){0.f, 0.f, 0.f, 0.f};
    bf16x8 At[4][2], B0[2][2], B1[2][2];
#define PG8_UA(u) ((u).kc < 0 ? (const char*)g.A + (size_t)(u).pm * tstepA : (const char*)g.A2 + (size_t)(u).pm * tstepA + (size_t)(u).kc * 1024)
#define PG8_UB(u) ((const char*)g.Bt + (size_t)(u).pn * tstepB + ((u).kc < 0 ? (size_t)0 : (size_t)(u).kc * 1024))
    const char* cA = PG8_UA(cur); const char* cB = PG8_UB(cur);
    PG8_STAGE(PG8_SB(0, 0), cB, voffB); PG8_STAGE(PG8_SB(0, 1), cB + hstepB, voffB); PG8_STAGE(PG8_SA(0, 0), cA, voffA); PG8_STAGE(PG8_SA(0, 1), cA + hstepA, voffA);
    if (wr == 1) PG8_BAR;
    PG8_WAIT_V(2); PG8_BAR;
    PG8_STAGE(PG8_SB(1, 0), cB + kstep, voffB); PG8_STAGE(PG8_SA(1, 0), cA + kstep, voffA); PG8_STAGE(PG8_SB(1, 1), cB + hstepB + kstep, voffB);
    PG8_WAIT_V(6); PG8_BAR;
    for (;;) {
        const bool has_next = S.next(ui + 1, nxt);
        const char* nA = has_next ? PG8_UA(nxt) : cA; const char* nB = has_next ? PG8_UB(nxt) : cB;
        const int ntu = cur.kc < 0 ? nt : 8;
        for (int t = 0; t < ntu; t += 2) {
            const bool last = (t == ntu - 2);
            const char* a1 = cA + (size_t)(t + 1) * kstep;
            const char* a2 = last ? nA : cA + (size_t)(t + 2) * kstep; const char* b2 = last ? nB : cB + (size_t)(t + 2) * kstep;
            const char* a3 = a2 + kstep; const char* b3 = b2 + kstep;
            PG8_LDB(B0, 0, 0); PG8_LDB(B1, 0, 1); PG8_SCHED; PG8_LDA(At, 0, 0); PG8_STAGE(PG8_SA(1, 1), a1 + hstepA, voffA);
            PG8_WAIT_V(8); PG8_WAIT_L(0); PG8_BAR; PG8_MMA(0, 0, At, B0); PG8_MMA(0, 1, At, B1); PG8_BAR; PG8_SCHED;
            PG8_LDA(At, 0, 1); PG8_STAGE(PG8_SB(0, 0), b2, voffB); PG8_STAGE(PG8_SB(0, 1), b2 + hstepB, voffB); PG8_STAGE(PG8_SA(0, 0), a2, voffA);
            PG8_WAIT_V(8); PG8_WAIT_L(0); PG8_BAR; PG8_MMA(1, 0, At, B0); PG8_MMA(1, 1, At, B1); PG8_BAR; PG8_SCHED;
            PG8_LDB(B0, 1, 0); PG8_LDB(B1, 1, 1); PG8_SCHED; PG8_LDA(At, 1, 0); PG8_STAGE(PG8_SA(0, 1), a2 + hstepA, voffA);
            PG8_WAIT_V(8); PG8_WAIT_L(0); PG8_BAR; PG8_MMA(0, 0, At, B0); PG8_MMA(0, 1, At, B1); PG8_BAR; PG8_SCHED;
            PG8_LDA(At, 1, 1); PG8_STAGE(PG8_SB(1, 0), b3, voffB); PG8_STAGE(PG8_SB(1, 1), b3 + hstepB, voffB); PG8_STAGE(PG8_SA(1, 0), a3, voffA);
            PG8_WAIT_V(8); PG8_WAIT_L(0); PG8_BAR; PG8_MMA(1, 0, At, B0); PG8_MMA(1, 1, At, B1); PG8_BAR; PG8_SCHED;
        }
        if (wr == 0) PG8_BAR;
        { const float* rp = cur.kc >= 0 ? rbs_tail : rbs;
          if (rp != nullptr) {
#pragma unroll
            for (int ai = 0; ai < 2; ++ai)
#pragma unroll
                for (int m = 0; m < 4; ++m) { const float rb = rsqrtf(rp[cur.pm * BM + ai * HALF + wr * 64 + m * 16 + fr] * (1.f / 2048.f) + EPS);
#pragma unroll
                    for (int bj = 0; bj < 2; ++bj)
#pragma unroll
                        for (int n = 0; n < 2; ++n) acc[ai][bj][m][n] = acc[ai][bj][m][n] * rb; } } }
        if (cur.kc >= 0) { EpiF32Perm E; E.C = g.P2 + (size_t)cur.kc * TCTX * 2048; E.ldc = 2048; E(acc, cur, wr, wc, fr, fq); }
        else if (mode == 0 && rvs != nullptr && ((cur.pn >= 24 && cur.pn < 32) || (cur.pn >= 40 && cur.pn < 48))) {
            const int j = cur.pn < 32 ? cur.pn - 24 : cur.pn - 32;
            bf16_t* O = (bf16_t*)Cout + ZC_U + 128 * j + wc * 32 + 8 * fq; const int row0 = cur.pm * BM + wr * 64 + fr;
#pragma unroll
            for (int ai = 0; ai < 2; ++ai)
#pragma unroll
                for (int m = 0; m < 4; ++m) { const f32x4 u0 = acc[ai][0][m][0], u1 = acc[ai][0][m][1], z0 = acc[ai][1][m][0], z1 = acc[ai][1][m][1];
                    u32x4 w; w.x = cvt_pk_bf16(u0[0] * silu_f(z0[0]), u0[1] * silu_f(z0[1])); w.y = cvt_pk_bf16(u0[2] * silu_f(z0[2]), u0[3] * silu_f(z0[3]));
                    w.z = cvt_pk_bf16(u1[0] * silu_f(z1[0]), u1[1] * silu_f(z1[1])); w.w = cvt_pk_bf16(u1[2] * silu_f(z1[2]), u1[3] * silu_f(z1[3]));
                    __builtin_nontemporal_store(w, (u32x4*)(O + (size_t)(row0 + ai * HALF + m * 16) * ldc)); } }
        else if (mode == 0) { EpiBf16 E; E.O = (bf16_t*)Cout; E.ldc = ldc; E(acc, cur, wr, wc, fr, fq);
            if (rvs != nullptr && (cur.pn >> 3) == 4) {
#pragma unroll
                for (int ai = 0; ai < 2; ++ai)
#pragma unroll
                    for (int m = 0; m < 4; ++m) { float ss = 0.f;
#pragma unroll
                        for (int bj = 0; bj < 2; ++bj)
#pragma unroll
                            for (int n = 0; n < 2; ++n) { const f32x4 v = acc[ai][bj][m][n]; ss += (v.x * v.x + v.y * v.y) + (v.z * v.z + v.w * v.w); }
                        ss += __shfl_xor(ss, 16); ss += __shfl_xor(ss, 32);
                        if (fq == 0) unsafeAtomicAdd(rvs + cur.pm * BM + ai * HALF + wr * 64 + m * 16 + fr, ss); } } }
        else { EpiF32 E; E.C = (float*)Cout; E.ldc = ldc; E(acc, cur, wr, wc, fr, fq); }
        if (!has_next) break;
#pragma unroll
        for (int a = 0; a < 2; ++a)
#pragma unroll
            for (int b = 0; b < 2; ++b)
#pragma unroll
                for (int m = 0; m < 4; ++m)
#pragma unroll
                    for (int n = 0; n < 2; ++n) acc[a][b][m][n] = (f32x4){0.f, 0.f, 0.f, 0.f};
        cur = nxt; cA = nA; cB = nB; ++ui;
        if (wr == 1) PG8_BAR;
    }
    PG8_WAIT_V(0);
    PG8_BAR;
#undef PG8_UA
#undef PG8_UB
#undef PG8_SA
#undef PG8_SB
#undef PG8_STAGE
#undef PG8_LDA
#undef PG8_LDB
#undef PG8_MMA
#undef PG8_WAIT_V
#undef PG8_WAIT_L
#undef PG8_BAR
#undef PG8_SCHED
}
}

#define XB_TMO      128
#define XB_XCNT(j)  (256  + 64 * (j))
#define XB_XSUB(j)  (1280 + 64 * (j))
#define XB_XGEN(j)  (2304 + 64 * (j))
#define XB_TOP      3328
#define XB_TOPGEN   3392
#define XCD_BAR_WORDS 3456
#define XB_SPIN_CAP (1u << 18)

__device__ __forceinline__ unsigned xb_ld(unsigned* p)              { return __hip_atomic_load(p, __ATOMIC_RELAXED, __HIP_MEMORY_SCOPE_AGENT); }
__device__ __forceinline__ unsigned xb_add(unsigned* p, unsigned v) { return __hip_atomic_fetch_add(p, v, __ATOMIC_RELAXED, __HIP_MEMORY_SCOPE_AGENT); }
__device__ __forceinline__ unsigned xb_xcc_id() { return (unsigned)__builtin_amdgcn_s_getreg((3 << 11) | 20) & 0xFu; }
#define XB_SPIN(cond, bar) do { unsigned _sp = 0; while (cond) { __builtin_amdgcn_s_sleep(1); \
    if ((++_sp & 255u) == 0u) { if (xb_ld(&(bar)[XB_TMO])) break; if (_sp > XB_SPIN_CAP) { atomicAdd(&(bar)[XB_TMO], 1u); break; } } } } while (0)

struct XcdBarrier {
    unsigned* bar; unsigned x;
    volatile LAS unsigned* st;
};

__device__ __forceinline__ XcdBarrier xcd_barrier_post(unsigned* bar, volatile LAS unsigned* st) {
    XcdBarrier b; b.bar = bar; b.x = xb_xcc_id(); b.st = st;
    if (threadIdx.x == 0) (void)xb_add(&bar[XB_XCNT(b.x)], 1u);
    return b;
}
__device__ __forceinline__ void xcd_barrier_complete(unsigned* bar, unsigned x, unsigned& nloc, unsigned& nx) {
    const unsigned G = gridDim.x * gridDim.y * gridDim.z;
    unsigned sum, cnt, mine, sp = 0u;
    for (;;) {
        sum = 0u; cnt = 0u; mine = 0u;
#pragma unroll
        for (unsigned j = 0; j < 16; ++j) { const unsigned c = xb_ld(&bar[XB_XCNT(j)]); sum += c; cnt += (c > 0u) ? 1u : 0u; mine = (j == x) ? c : mine; }
        if (sum == G) break;
        __builtin_amdgcn_s_sleep(1);
        if ((++sp & 255u) == 0u) { if (xb_ld(&bar[XB_TMO])) break; if (sp > XB_SPIN_CAP) { atomicAdd(&bar[XB_TMO], 1u); break; } }
    }
    nloc = mine > 0u ? mine : 1u; nx = cnt > 0u ? cnt : 1u;
}

__device__ __forceinline__ void xcd_barrier(const XcdBarrier& b) {
    asm volatile("s_waitcnt vmcnt(0)" ::: "memory");
    __syncthreads();
    if (threadIdx.x == 0) {
        unsigned* bar = b.bar;
        __builtin_amdgcn_s_waitcnt(0);
        unsigned nloc = b.st[0], nx = b.st[1];
        if (nloc == 0u) { xcd_barrier_complete(bar, b.x, nloc, nx); b.st[0] = nloc; b.st[1] = nx; }
        const unsigned old = xb_add(&bar[XB_XSUB(b.x)], 1u);
        const unsigned gen = old / nloc;
        if (old + 1u == (gen + 1u) * nloc) {
            __builtin_amdgcn_fence(__ATOMIC_RELEASE, "agent");
            asm volatile("s_waitcnt vmcnt(0)" ::: "memory");
            const unsigned og = xb_add(&bar[XB_TOP], 1u);
            const unsigned tg = og / nx;
            if (og + 1u == (tg + 1u) * nx) xb_add(&bar[XB_TOPGEN], 1u);
            else XB_SPIN(xb_ld(&bar[XB_TOPGEN]) == tg, bar);
            __builtin_amdgcn_fence(__ATOMIC_ACQUIRE, "agent");
            xb_add(&bar[XB_XGEN(b.x)], 1u);
            asm volatile("s_waitcnt vmcnt(0)" ::: "memory");
        } else {
            XB_SPIN(xb_ld(&bar[XB_XGEN(b.x)]) == gen, bar);
            __builtin_amdgcn_fence(__ATOMIC_ACQUIRE, "agent");
            asm volatile("s_waitcnt vmcnt(0)" ::: "memory");
        }
    }
    __syncthreads();
}


__device__ __forceinline__ void transpose_item(const float* W, int ldw, int srcc0, int k0, bf16_t* WT, int ldk, int n0, bool zero, LAS float* scr, int lane, const float* kscale = nullptr) {
    if (!zero) {
        f32x4 v[8];
#pragma unroll
        for (int i = 0; i < 8; ++i) { const int kk = (lane >> 3) + 8 * i; v[i] = *(const f32x4*)(W + (size_t)(k0 + kk) * ldw + srcc0 + (lane & 7) * 4); }
#pragma unroll
        for (int i = 0; i < 8; ++i) { const int kk = (lane >> 3) + 8 * i; LAS float* d = scr + kk * 33 + (lane & 7) * 4; const float sc = kscale ? kscale[kk] : 1.f; d[0] = v[i].x * sc; d[1] = v[i].y * sc; d[2] = v[i].z * sc; d[3] = v[i].w * sc; }
    }
    asm volatile("s_waitcnt lgkmcnt(0)" ::: "memory");
    const int c = lane & 7;
#pragma unroll
    for (int j = 0; j < 4; ++j) { const int n = (lane >> 3) + 8 * j; const LAS float* s = scr + (8 * c) * 33 + n;
        u32x4 o;
        if (zero) { o = (u32x4){0u, 0u, 0u, 0u}; }
        else { o.x = cvt_pk_bf16(s[0 * 33], s[1 * 33]); o.y = cvt_pk_bf16(s[2 * 33], s[3 * 33]); o.z = cvt_pk_bf16(s[4 * 33], s[5 * 33]); o.w = cvt_pk_bf16(s[6 * 33], s[7 * 33]); }
        *(u32x4*)(WT + (size_t)(n0 + n) * ldk + k0 + 8 * c) = o; }
    asm volatile("s_waitcnt lgkmcnt(0)" ::: "memory");
}

__device__ __forceinline__ void convert_layer_weights(const Args& a, unsigned char* ws, const int l, const int gw, const int NGW, LAS unsigned char* lds, const int wave, const int lane) {
    LAS float* scr = (LAS float*)(lds + wave * 16384);
    constexpr int I_IN = 32 * 392, I_OUT = 64 * 64;
    bf16_t* WinT = (bf16_t*)(ws + WS_WIN); bf16_t* WoutT = (bf16_t*)(ws + WS_WOUT);
    for (int it = gw; it < I_IN + I_OUT; it += NGW) {
        if (it < I_IN) {
            const int kb = it / 392, nb = it % 392, n0 = nb * 32;
            int src; bool zero = false;
            if (n0 < 4096) src = n0; else if (n0 < 6144) src = 4160 + (n0 - 4096);
            else if (n0 < 8192 || (n0 >= 10240 && n0 < 12288)) {
                const int rel = n0 < 8192 ? n0 - 6144 : n0 - 10240 + 2048, j = rel >> 8, cc = rel & 255; src = cc < 128 ? 6208 + 128 * j + cc : 10304 + 128 * j + (cc - 128); }
            else if (n0 < 10240) src = 8256 + (n0 - 8192); else if (n0 < 12352) src = 4096 + (n0 - 12288); else { src = 0; zero = true; }
            transpose_item(INP(8) + (size_t)l * 2048 * INW, INW, src, kb * 64, WinT + (size_t)l * ZW * 2048, 2048, n0, zero, scr, lane);
        } else {
            const int r = it - I_IN, kb = r / 64, nb = r % 64;
            transpose_item(INP(19) + (size_t)l * 4096 * 2048, 2048, nb * 32, kb * 64, WoutT + (size_t)l * 2048 * 4096, 4096, nb * 32, false, scr, lane, kb >= 32 ? INP(18) + l * 2048 + (kb * 64 - 2048) : (const float*)nullptr);
        }
    }
}

__device__ __forceinline__ void phase_prologue(const Args& a, unsigned char* ws, const int bid, LAS unsigned char* lds, int tid, int wave, int lane) {
    const int G = gridDim.x;
    {
        LAS float* sc = (LAS float*)lds;
        LAS float* part = (LAS float*)(lds + 40960);
        const float* c = INP(1); const float* cctx = INP(3);
        for (int i = tid; i < 5 * 2048; i += 512) { const int s = i >> 11, k = i & 2047; const float cv = s < 4 ? c[s * 2048 + k] : cctx[k]; sc[i] = silu_f(cv); }
        __syncthreads();
        float* mod = (float*)(ws + WS_MOD);
        for (int item = bid; item < 192; item += G) {
            const int l = item / 48, cb = item % 48, col0 = cb * 128;
            const float* W = INP(4) + (size_t)l * 2048 * 6144 + col0 + lane * 2;
            float acc[5][2];
#pragma unroll
            for (int s = 0; s < 5; ++s) { acc[s][0] = 0.f; acc[s][1] = 0.f; }
            const int k0 = wave * 256;
#pragma unroll 8
            for (int k = k0; k < k0 + 256; ++k) { const f32x2 w = *(const f32x2*)(W + (size_t)k * 6144);
#pragma unroll
                for (int s = 0; s < 5; ++s) { const float sv = sc[s * 2048 + k]; acc[s][0] += sv * w.x; acc[s][1] += sv * w.y; } }
#pragma unroll
            for (int s = 0; s < 5; ++s) { part[(wave * 5 + s) * 128 + lane * 2] = acc[s][0]; part[(wave * 5 + s) * 128 + lane * 2 + 1] = acc[s][1]; }
            __syncthreads();
            for (int i = tid; i < 640; i += 512) { const int s = i >> 7, cc = i & 127; float v = INP(5)[l * 6144 + col0 + cc];
#pragma unroll
                for (int w = 0; w < 8; ++w) v += part[(w * 5 + s) * 128 + cc];
                const int col = col0 + cc;
                if (col >= 4096) v *= INP(7)[l * 2048 + col - 4096]; else if (col >= 2048) v = (1.f + v) * INP(6)[l * 2048 + col - 2048];
                mod[(size_t)(l * 5 + s) * 6144 + col] = v; }
            __syncthreads();
        }
    }
    {
        bf16_t* wsb = (bf16_t*)(ws + WS_WSB); const float* w_s = INP(16);
        for (int i = (bid * 512 + tid) * 4; i < 4 * 16 * 16384; i += G * 512 * 4) { const f32x4 v = *(const f32x4*)(w_s + i);
            u32x2 o; o.x = cvt_pk_bf16(v.x, v.y); o.y = cvt_pk_bf16(v.z, v.w); *(u32x2*)(wsb + i) = o; }
    }
    convert_layer_weights(a, ws, 0, bid * 8 + wave, G * 8, lds, wave, lane);
}

__device__ __forceinline__ void phase_A(const Args& a, unsigned char* ws, const int bid, int l, int wave, int lane) {
    const int gw = bid * 8 + wave, NGW = gridDim.x * 8;
    const float* mod = (const float*)(ws + WS_MOD);
    float* ctxall = (float*)(ws + WS_CTX);
    bf16_t* hx = (bf16_t*)(ws + WS_HX);
    const bf16_t* z = (const bf16_t*)(ws + WS_Z);
#pragma unroll 1
    for (int seg = (l == 4 ? 1 : 0); seg < 5; ++seg) {
        const int s = seg == 0 ? 4 : seg - 1, rbeg = seg == 0 ? 0 : TCTX + (seg - 1) * SEQ, rend = seg == 0 ? TCTX : rbeg + SEQ;
        f32x4 G2[8], S2[8], SH[8];
        if (l >= 1) { const float* gp = mod + (size_t)((l - 1) * 5 + s) * 6144 + 4096 + lane * 4;
#pragma unroll
            for (int j = 0; j < 8; ++j) G2[j] = *(const f32x4*)(gp + j * 256); }
        if (l < 4) { const float* sp = mod + (size_t)(l * 5 + s) * 6144 + lane * 4;
#pragma unroll
            for (int j = 0; j < 8; ++j) { SH[j] = *(const f32x4*)(sp + j * 256); S2[j] = *(const f32x4*)(sp + 2048 + j * 256); } }
#pragma unroll 1
        for (int r = rbeg + gw; r < rend; r += NGW) {
            if (l < 4 && lane == 0) { ((float*)(ws + WS_RVS))[r] = 0.f; ((float*)(ws + WS_YBS))[r] = 0.f; }
            const float* src; float* dst;
            if (r < TCTX) { dst = ctxall + (size_t)r * D; src = (l <= 1) ? INP(2) + (size_t)r * D : dst; }
            else { dst = a.out + (size_t)(r - TCTX) * D; src = (l <= 1) ? INP(0) + (size_t)(r - TCTX) * D : dst; }
            f32x4 xv[8];
#pragma unroll
            for (int j = 0; j < 8; ++j) xv[j] = *(const f32x4*)(src + j * 256 + lane * 4);
            if (l >= 1) {
                const bf16_t* orow = z + (size_t)r * ZW;
                f32x4 ov[8]; float ss = 0.f;
                if (r < TCTX) {
                    const float* pp = (const float*)(ws + WS_XBC) + (size_t)r * 2048 + lane * 4;
#pragma unroll
                    for (int j = 0; j < 8; ++j) { f32x4 acc4 = *(const f32x4*)(pp + j * 256);
#pragma unroll
                        for (int kc = 1; kc < 8; ++kc) acc4 = acc4 + *(const f32x4*)(pp + (size_t)kc * TCTX * 2048 + j * 256);
                        ov[j] = acc4; }
                } else {
#pragma unroll
                    for (int j = 0; j < 8; ++j) { const u32x2 ob = *(const u32x2*)(orow + j * 256 + lane * 4); ov[j] = (f32x4){bflo(ob.x), bfhi(ob.x), bflo(ob.y), bfhi(ob.y)}; }
                }
#pragma unroll
                for (int j = 0; j < 8; ++j) ss += (ov[j].x * ov[j].x + ov[j].y * ov[j].y) + (ov[j].z * ov[j].z + ov[j].w * ov[j].w);
                const float ro = rsqrtf(wave_sum(ss) * (1.f / D) + EPS);
#pragma unroll
                for (int j = 0; j < 8; ++j) { xv[j] = xv[j] + G2[j] * (ov[j] * ro); *(f32x4*)(dst + j * 256 + lane * 4) = xv[j]; }
            }
            if (l < 4) {
                float ss = 0.f;
#pragma unroll
                for (int j = 0; j < 8; ++j) ss += (xv[j].x * xv[j].x + xv[j].y * xv[j].y) + (xv[j].z * xv[j].z + xv[j].w * xv[j].w);
                const float rx = rsqrtf(wave_sum(ss) * (1.f / D) + EPS);
#pragma unroll
                for (int j = 0; j < 8; ++j) { const int col = j * 256 + lane * 4;
                    const f32x4 hv = (xv[j] * rx) * S2[j] + SH[j];
                    u32x2 o; o.x = cvt_pk_bf16(hv.x, hv.y); o.y = cvt_pk_bf16(hv.z, hv.w);
                    *(u32x2*)(hx + (size_t)r * D + col) = o; }
            }
        }
    }
}

__device__ __forceinline__ void mlp_phase(const Args& a, unsigned char* ws, const int bid, int l, LAS unsigned char* lds, int tid, int wave, int lane) {
    bf16_t* z = (bf16_t*)(ws + WS_Z);
    const bf16_t* wsb = (const bf16_t*)(ws + WS_WSB) + (size_t)l * 16 * 16384;
    const float* rvs = (const float*)(ws + WS_RVS); float* ybs = (float*)(ws + WS_YBS);
    const float* g_v = INP(15) + l * 2048; const float* b_s = INP(17) + l * 16 * 128;
    LAS unsigned char* L_W = lds; LAS unsigned char* L_V = lds + 34816;
    const int fr = lane & 15, fq = lane >> 4, wr = wave >> 1, wc = wave & 1;
    const int G = gridDim.x;
    u32x4 tw[4], tv[4]; float trk[4]; f32x4 tg0, tg1;
    const bool wfixed = (G & 15) == 0;
#define MLP_ISSUE(it) do { const int _gc = (it) >> 4, _g = (it) & 15; \
        _Pragma("unroll") for (int i = 0; i < 4; ++i) { const int p = tid + i * 512, r = p >> 4, cp = p & 15; \
            if (!wfixed) tw[i] = *(const u32x4*)(wsb + (size_t)_g * 16384 + r * 128 + cp * 8); \
            tv[i] = *(const u32x4*)(z + (size_t)(_gc * 128 + r) * ZW + ZC_V + _g * 128 + cp * 8); \
            trk[i] = rvs[_gc * 128 + r]; } \
        tg0 = *(const f32x4*)(g_v + _g * 128 + (tid & 15) * 8); tg1 = *(const f32x4*)(g_v + _g * 128 + (tid & 15) * 8 + 4); } while (0)
    if (wfixed && bid < NCH * 16) {
#pragma unroll
        for (int i = 0; i < 4; ++i) { const int p = tid + i * 512, r = p >> 4, cp = p & 15; *(LAS u32x4*)(L_W + r * 272 + cp * 16) = *(const u32x4*)(wsb + (size_t)(bid & 15) * 16384 + r * 128 + cp * 8); } }
    if (bid < NCH * 16) MLP_ISSUE(bid);
#pragma unroll 1
    for (int it = bid; it < NCH * 16; it += G) {
        const int gc = it >> 4, g = it & 15, row0 = gc * 128;
#pragma unroll
        for (int i = 0; i < 4; ++i) { const int p = tid + i * 512, r = p >> 4, cp = p & 15;
            if (!wfixed) *(LAS u32x4*)(L_W + r * 272 + cp * 16) = tw[i];
            float f[8]; unpack8(tv[i], f); const float rk = rsqrtf(trk[i] * (1.f / 2048.f) + EPS);
            const f32x4 g0 = tg0, g1 = tg1;
            float o[8] = {f[0] * rk * g0.x, f[1] * rk * g0.y, f[2] * rk * g0.z, f[3] * rk * g0.w, f[4] * rk * g1.x, f[5] * rk * g1.y, f[6] * rk * g1.z, f[7] * rk * g1.w};
            *(LAS u32x4*)(L_V + offb(r, cp)) = pack8(o); }
        u32x4 pu[2][2]; float pbias[2];
#pragma unroll
        for (int i = 0; i < 2; ++i) { const int q = (2 * wr + i) * 16 + fr; const bf16_t* zr = z + (size_t)(row0 + q) * ZW; pbias[i] = b_s[g * 128 + q];
#pragma unroll
            for (int m = 0; m < 2; ++m) { const int d0 = g * 128 + 32 * (2 * wc + m) + 8 * fq; pu[i][m] = *(const u32x4*)(zr + ZC_U + d0); } }
        LDS_BARRIER();
        if (it + G < NCH * 16) MLP_ISSUE(it + G);
        f32x4 acc[2][4];
#pragma unroll
        for (int i = 0; i < 2; ++i)
#pragma unroll
            for (int j = 0; j < 4; ++j) acc[i][j] = (f32x4){0.f, 0.f, 0.f, 0.f};
#pragma unroll
        for (int s = 0; s < 4; ++s) { bf16x8 wf[2], vf[4];
#pragma unroll
            for (int i = 0; i < 2; ++i) wf[i] = *(const LAS bf16x8*)(L_W + ((2 * wr + i) * 16 + fr) * 272 + s * 64 + fq * 16);
#pragma unroll
            for (int j = 0; j < 4; ++j) vf[j] = ldfrag_tr_bp(L_V, 32 * s, 4 * wc + j, lane);
            __builtin_amdgcn_sched_barrier(0);
#pragma unroll
            for (int i = 0; i < 2; ++i)
#pragma unroll
                for (int j = 0; j < 4; ++j) acc[i][j] = MFMA16(vf[j], wf[i], acc[i][j]);
            __builtin_amdgcn_sched_barrier(0); }
#pragma unroll
        for (int i = 0; i < 2; ++i) { const int q = (2 * wr + i) * 16 + fr; const float bias = pbias[i];
            bf16_t* zr = z + (size_t)(row0 + q) * ZW; float ss = 0.f;
#pragma unroll
            for (int m = 0; m < 2; ++m) { const int d0 = g * 128 + 32 * (2 * wc + m) + 8 * fq;
                float uf[8]; unpack8(pu[i][m], uf);
                float o[8];
#pragma unroll
                for (int r = 0; r < 4; ++r) { o[r] = uf[r] * (acc[i][2 * m][r] + bias); o[4 + r] = uf[4 + r] * (acc[i][2 * m + 1][r] + bias); }
#pragma unroll
                for (int e = 0; e < 8; ++e) ss += o[e] * o[e];
                *(u32x4*)(zr + ZC_U + d0) = pack8(o); }
            ss += __shfl_xor(ss, 16); ss += __shfl_xor(ss, 32);
            if (fq == 0) unsafeAtomicAdd(ybs + row0 + q, ss); }
        LDS_BARRIER();
    }
#undef MLP_ISSUE
}

__device__ __forceinline__ void conv_stream(const Args& a, unsigned char* ws, const int bid, int l, int tid) {
    const bf16_t* z = (const bf16_t*)(ws + WS_Z); bf16_t* xbc = (bf16_t*)(ws + WS_XBC);
    const int c0 = tid * 8;
    const float* cw = INP(9) + (size_t)l * 5 * 4096 + c0; const float* cbias = INP(10) + l * 4096 + c0;
    float w[5][8], bias[8];
#pragma unroll
    for (int k = 0; k < 5; ++k) { const f32x4 w0 = *(const f32x4*)(cw + k * 4096), w1 = *(const f32x4*)(cw + k * 4096 + 4);
        w[k][0] = w0.x; w[k][1] = w0.y; w[k][2] = w0.z; w[k][3] = w0.w; w[k][4] = w1.x; w[k][5] = w1.y; w[k][6] = w1.z; w[k][7] = w1.w; }
    { const f32x4 b0 = *(const f32x4*)cbias, b1 = *(const f32x4*)(cbias + 4); bias[0] = b0.x; bias[1] = b0.y; bias[2] = b0.z; bias[3] = b0.w; bias[4] = b1.x; bias[5] = b1.y; bias[6] = b1.z; bias[7] = b1.w; }
    for (int tg = bid; tg < T / 8; tg += gridDim.x) {
        const int tb = tg * 8;
        bool lo_ok, hi_ok;
        if (tb < TCTX) { lo_ok = (tb & 255) != 0; hi_ok = ((tb + 8) & 255) != 0; }
        else { lo_ok = ((tb - TCTX) & 63) != 0; hi_ok = ((tb + 8 - TCTX) & 63) != 0; }
        u32x4 rows[12];
#pragma unroll
        for (int j = 0; j < 12; ++j) { const bool ok = (j >= 2 && j < 10) || (j < 2 && lo_ok) || (j >= 10 && hi_ok);
            rows[j] = ok ? *(const u32x4*)(z + (size_t)(tb - 2 + j) * ZW + c0) : (u32x4){0u, 0u, 0u, 0u}; }
#pragma unroll
        for (int e = 0; e < 8; ++e) { float acc[8];
#pragma unroll
            for (int c = 0; c < 8; ++c) acc[c] = bias[c];
#pragma unroll
            for (int k = 0; k < 5; ++k) { float f[8]; unpack8(rows[e + k], f);
#pragma unroll
                for (int c = 0; c < 8; ++c) acc[c] += w[k][c] * f[c]; }
#pragma unroll
            for (int c = 0; c < 8; ++c) acc[c] = silu_f(acc[c]);
            *(u32x4*)(xbc + (size_t)(tb + e) * 4096 + c0) = pack8(acc); }
    }
}

__device__ __forceinline__ void phase_C0(const Args& a, unsigned char* ws, const int bid, int l, LAS unsigned char* lds, int tid, int wave, int lane) {
    const int G = gridDim.x;
    { const bf16_t* z = (const bf16_t*)(ws + WS_Z); float* DT = (float*)(ws + WS_DT); const float* dtb = INP(11) + l * 64;
      for (int idx = bid * 512 + tid; idx < T * 64; idx += G * 512) { const int t = idx >> 6, j = idx & 63;
          const float xr = bf1(z[(size_t)t * ZW + ZC_DT + j]) + dtb[j];
          const float e = __expf(-fabsf(xr)), u = 1.f + e;
          const float l1p = (u == 1.f) ? e : __logf(u) * e * __builtin_amdgcn_rcpf(u - 1.f);
          DT[idx] = fmaxf(xr, 0.f) + l1p; } }
    mlp_phase(a, ws, bid, l, lds, tid, wave, lane);
    conv_stream(a, ws, bid, l, tid);
#ifdef CONV_REP
    conv_stream(a, ws, bid, l, tid);
#endif
}

__device__ __forceinline__ void phase_C1(const Args& a, unsigned char* ws, const int bid, int l, LAS unsigned char* lds, int tid, int wave, int lane) {
    bf16_t* z = (bf16_t*)(ws + WS_Z);
    const bf16_t* xbc = (const bf16_t*)(ws + WS_XBC);
    const float* DT = (const float*)(ws + WS_DT);
    LAS unsigned char* L_C = lds; LAS unsigned char* L_B = lds + 34816; LAS unsigned char* L_M = lds + 69632; LAS unsigned char* L_X = lds + 104448; LAS unsigned char* L_H = lds + 122880;
    LAS float* cs = (LAS float*)(lds + 140288); LAS float* dtv = cs + 128; LAS float* wgt = cs + 256; LAS float* ecs = cs + 384; LAS float* f2dt = cs + 512; LAS float* refarr = cs + 640; LAS float* totp = cs + 656;
    const int fr = lane & 15, fq = lane >> 4, wr = wave >> 1, wc = wave & 1;
    const int qt = wave < 4 ? wave : 11 - wave;
    const int rb = fr * 272 + fq * 16;
    const int trB = (8 * fq + (fr >> 2)) * 272 + 8 * (lane & 3);
    const int trX = (8 * fq + (fr >> 2)) * 144 + 8 * (lane & 3);
    const int trXp = (8 * fq + (fr >> 2)) * 144 + 16 * (lane & 3);
    const int rbH = (8 * (fr >> 2) + (fr & 3)) * 272 + fq * 16;
    const unsigned offCB = (unsigned)(tid >> 4) * 4096u + (unsigned)(tid & 15) * 8u, offX = (unsigned)(tid >> 3) * 4096u + (unsigned)(tid & 7) * 8u;
    const int wCB = (tid >> 4) * 272 + (tid & 15) * 16, wX = (tid >> 3) * 144 + (tid & 7) * 16;
#define TRB(base, krow0, col0, t) __builtin_amdgcn_ds_read_tr16_b64_v4i16((LAS s16x4*)((base) + trB + ((krow0) + 4 * (t)) * 272 + (col0) * 2))
#define TRX(base, krow0, col0, t) __builtin_amdgcn_ds_read_tr16_b64_v4i16((LAS s16x4*)((base) + trX + ((krow0) + 4 * (t)) * 144 + (col0) * 2))
    for (int item = bid; item < 256; item += gridDim.x) {
        const int combo = (item & 7) * 8 + (item >> 5), hq = (item >> 3) & 3;
        const int b = combo >> 4, g = (combo >> 1) & 7, dir = combo & 1, h = 4 * g + hq;
        const float Acoef = -__expf(INP(12)[l * 64 + dir * 32 + h]);
        const float dskip = INP(13)[l * 32 + h];
        f32x4 Hacc[4];
#pragma unroll
        for (int j = 0; j < 4; ++j) Hacc[j] = (f32x4){0.f, 0.f, 0.f, 0.f};
        for (int i = tid; i < 17408 / 4; i += 512) ((LAS unsigned*)L_H)[i] = 0u;
        u32x4 pc[4], pb[4], px[2]; float pd0 = 0.f, pd1 = 0.f;
#define SSD_GC(step) ((dir == 0) ? ((step) < 2 ? 2 * b + (step) : 8 + b * 64 + ((step) - 2)) : ((step) < 2 ? 2 * b + (1 - (step)) : 8 + b * 64 + (65 - (step))))
#define SSD_ISSUE(step) do { const int _r0 = SSD_GC(step) * 128; const bf16_t* _cb = xbc + (size_t)_r0 * 4096 + 2048 + g * 128; const bf16_t* _xb = xbc + (size_t)_r0 * 4096 + h * 64; \
            _Pragma("unroll") for (int i = 0; i < 4; ++i) { pc[i] = *(const u32x4*)(_cb + 1024 + (size_t)i * 32 * 4096 + offCB); pb[i] = *(const u32x4*)(_cb + (size_t)i * 32 * 4096 + offCB); } \
            _Pragma("unroll") for (int i = 0; i < 2; ++i) px[i] = *(const u32x4*)(_xb + (size_t)i * 64 * 4096 + offX); \
            if (wave == 0) { pd0 = DT[(size_t)(_r0 + 2 * lane) * 64 + dir * 32 + h]; pd1 = DT[(size_t)(_r0 + 2 * lane + 1) * 64 + dir * 32 + h]; } } while (0)
        SSD_ISSUE(0);
#pragma unroll 1
        for (int step = 0; step < 66; ++step) {
            const int row0 = SSD_GC(step) * 128;
#pragma unroll
            for (int i = 0; i < 4; ++i) { *(LAS u32x4*)(L_C + wCB + i * 32 * 272) = pc[i]; *(LAS u32x4*)(L_B + wCB + i * 32 * 272) = pb[i]; }
#pragma unroll
            for (int i = 0; i < 2; ++i) *(LAS u32x4*)(L_X + wX + i * 64 * 144) = px[i];
            if (wave == 0) {
                const int t0 = 2 * lane;
                const float d0 = pd0, d1 = pd1;
                const float a0 = d0 * Acoef, a1 = d1 * Acoef, pair = a0 + a1; const float incl = wave_incl_scan(pair);
                const float tot = __builtin_bit_cast(float, __builtin_amdgcn_readlane(__builtin_bit_cast(int, incl), 63)), excl = incl - pair;
                float c0v, c1v, ref;
                if (dir == 0) { c0v = excl + a0; c1v = incl; ref = __shfl(c1v, (lane & ~7) + 7); }
                else { c0v = tot - excl; c1v = tot - incl + a1; ref = __shfl(c0v, lane & ~7); }
                cs[t0] = c0v; cs[t0 + 1] = c1v; dtv[t0] = d0; dtv[t0 + 1] = d1;
                wgt[t0] = d0 * __expf(tot - c0v); wgt[t0 + 1] = d1 * __expf(tot - c1v);
                ecs[t0] = __expf(c0v); ecs[t0 + 1] = __expf(c1v);
                f2dt[t0] = d0 * __expf(ref - c0v); f2dt[t0 + 1] = d1 * __expf(ref - c1v);
                if ((lane & 7) == 0) refarr[lane >> 3] = ref;
                if (lane == 0) totp[0] = tot;
            }
            LDS_BARRIER();
            if (step + 1 < 66) SSD_ISSUE(step + 1);
            f32x4 accA[8], accC[4];
#pragma unroll
            for (int j = 0; j < 8; ++j) accA[j] = (f32x4){0.f, 0.f, 0.f, 0.f};
#pragma unroll
            for (int j = 0; j < 4; ++j) accC[j] = (f32x4){0.f, 0.f, 0.f, 0.f};
            {
                bf16x8 cqv[2], bq[2][4], hq[2][2];
#define SSD_LDH(buf, h_) do { const int _s = (h_) >> 1, _hf = (h_) & 1; if (_hf == 0) cqv[_s & 1] = *(const LAS bf16x8*)(L_C + qt * (16 * 272) + rb + _s * 64); \
                    _Pragma("unroll") for (int k = 0; k < 4; ++k) bq[buf][k] = *(const LAS bf16x8*)(L_B + (4 * _hf + k) * (16 * 272) + rb + _s * 64); \
                    _Pragma("unroll") for (int p = 0; p < 2; ++p) hq[buf][p] = *(const LAS bf16x8*)(L_H + (32 * _hf + 4 * p) * 272 + rbH + _s * 64); } while (0)
                SSD_LDH(0, 0);
#pragma unroll
                for (int h2 = 0; h2 < 8; ++h2) { const int cb = h2 & 1, s_ = h2 >> 1, hf_ = h2 & 1;
                    if (h2 < 7) SSD_LDH(cb ^ 1, h2 + 1);
                    __builtin_amdgcn_sched_barrier(0);
#pragma unroll
                    for (int k = 0; k < 4; ++k) accA[4 * hf_ + k] = MFMA16(bq[cb][k], cqv[s_ & 1], accA[4 * hf_ + k]);
#pragma unroll
                    for (int p = 0; p < 2; ++p) accC[2 * hf_ + p] = MFMA16(hq[cb][p], cqv[s_ & 1], accC[2 * hf_ + p]);
                    __builtin_amdgcn_sched_barrier(0); }
#undef SSD_LDH
            }
            { const float etot = __expf(totp[0]);
#pragma unroll
              for (int j = 0; j < 4; ++j) Hacc[j] = Hacc[j] * etot;
#pragma unroll
              for (int s = 0; s < 4; ++s) { const s16x4 xlo = TRX(L_X, 32 * s, 16 * wr, 0), xhi = TRX(L_X, 32 * s, 16 * wr, 1);
                  const f32x4 w0 = *(const LAS f32x4*)(wgt + s * 32 + fq * 8), w1 = *(const LAS f32x4*)(wgt + s * 32 + fq * 8 + 4);
                  s16x4 blo[4], bhi[4];
#pragma unroll
                  for (int j = 0; j < 4; ++j) { blo[j] = TRB(L_B, 32 * s, 16 * (4 * wc + j), 0); bhi[j] = TRB(L_B, 32 * s, 16 * (4 * wc + j), 1); }
                  __builtin_amdgcn_sched_barrier(0);
                  const u32x2 xl = __builtin_bit_cast(u32x2, xlo), xh = __builtin_bit_cast(u32x2, xhi);
                  u32x4 xs; xs.x = cvt_pk_bf16(bflo(xl.x) * w0.x, bfhi(xl.x) * w0.y); xs.y = cvt_pk_bf16(bflo(xl.y) * w0.z, bfhi(xl.y) * w0.w);
                  xs.z = cvt_pk_bf16(bflo(xh.x) * w1.x, bfhi(xh.x) * w1.y); xs.w = cvt_pk_bf16(bflo(xh.y) * w1.z, bfhi(xh.y) * w1.w);
                  const bf16x8 xq = __builtin_bit_cast(bf16x8, xs);
#pragma unroll
                  for (int j = 0; j < 4; ++j) { const bf16x8 bt = (bf16x8){blo[j].x, blo[j].y, blo[j].z, blo[j].w, bhi[j].x, bhi[j].y, bhi[j].z, bhi[j].w};
                      Hacc[j] = MFMA16(bt, xq, Hacc[j]); }
                  __builtin_amdgcn_sched_barrier(0); } }
            { const int q = qt * 16 + fr; const float csq = cs[q], eq = ecs[q];
              f32x4 gd = accA[0];
#pragma unroll
              for (int kt = 1; kt < 8; ++kt) { const bool is = (kt == qt); gd.x = is ? accA[kt].x : gd.x; gd.y = is ? accA[kt].y : gd.y; gd.z = is ? accA[kt].z : gd.z; gd.w = is ? accA[kt].w : gd.w; }
#pragma unroll
              for (int kt = 0; kt < 8; ++kt) { const int k0 = kt * 16 + fq * 4;
                  const bool kept = dir == 0 ? (kt < qt) : (kt > qt);
                  const float f1 = __expf(csq - refarr[kt]); const f32x4 f2 = *(const LAS f32x4*)(f2dt + k0);
                  float m[4];
#pragma unroll
                  for (int r = 0; r < 4; ++r) m[r] = kept ? accA[kt][r] * f1 * f2[r] : 0.f;
                  u32x2 o; o.x = cvt_pk_bf16(m[0], m[1]); o.y = cvt_pk_bf16(m[2], m[3]);
                  *(LAS u32x2*)(L_M + q * 272 + k0 * 2) = o; }
              { const int k0 = qt * 16 + fq * 4; const f32x4 ck = *(const LAS f32x4*)(cs + k0), dk = *(const LAS f32x4*)(dtv + k0); float m[4];
#pragma unroll
                for (int r = 0; r < 4; ++r) { const int kk = k0 + r; const bool keep = dir == 0 ? (kk <= q) : (kk >= q); m[r] = keep ? gd[r] * __expf(csq - ck[r]) * dk[r] : 0.f; }
                u32x2 o; o.x = cvt_pk_bf16(m[0], m[1]); o.y = cvt_pk_bf16(m[2], m[3]);
                *(LAS u32x2*)(L_M + q * 272 + k0 * 2) = o; }
              f32x4 accB[4];
#pragma unroll
              for (int j = 0; j < 4; ++j) accB[j] = (f32x4){0.f, 0.f, 0.f, 0.f};
#pragma unroll
              for (int s = 0; s < 4; ++s) { const bf16x8 mq = *(const LAS bf16x8*)(L_M + qt * (16 * 272) + rb + s * 64);
                  s16x4 xlo[4], xhi[4];
#pragma unroll
                  for (int pt = 0; pt < 4; ++pt) { xlo[pt] = __builtin_amdgcn_ds_read_tr16_b64_v4i16((LAS s16x4*)(L_X + trXp + (32 * s) * 144 + (32 * (pt >> 1) + 4 * (pt & 1)) * 2));
                      xhi[pt] = __builtin_amdgcn_ds_read_tr16_b64_v4i16((LAS s16x4*)(L_X + trXp + (32 * s + 4) * 144 + (32 * (pt >> 1) + 4 * (pt & 1)) * 2)); }
                  __builtin_amdgcn_sched_barrier(0);
#pragma unroll
                  for (int pt = 0; pt < 4; ++pt) { const bf16x8 xf = (bf16x8){xlo[pt].x, xlo[pt].y, xlo[pt].z, xlo[pt].w, xhi[pt].x, xhi[pt].y, xhi[pt].z, xhi[pt].w}; accB[pt] = MFMA16(xf, mq, accB[pt]); }
                  __builtin_amdgcn_sched_barrier(0); }
              bf16_t* yrow = z + (size_t)(row0 + q) * ZW + dir * 2048 + h * 64 + 8 * fq;
#pragma unroll
              for (int m = 0; m < 2; ++m) { float y[8];
#pragma unroll
                  for (int r = 0; r < 4; ++r) { y[r] = accB[2 * m][r] + eq * accC[2 * m][r]; y[4 + r] = accB[2 * m + 1][r] + eq * accC[2 * m + 1][r]; }
                  if (dir == 0) { const u32x4 xv = *(const LAS u32x4*)(L_X + q * 144 + (32 * m + 8 * fq) * 2); float xf8[8]; unpack8(xv, xf8);
#pragma unroll
                      for (int e = 0; e < 8; ++e) y[e] += dskip * xf8[e]; }
                  *(u32x4*)(yrow + 32 * m) = pack8(y); } }
            LDS_BARRIER();
#pragma unroll
            for (int j = 0; j < 4; ++j) { u32x2 o; o.x = cvt_pk_bf16(Hacc[j][0], Hacc[j][1]); o.y = cvt_pk_bf16(Hacc[j][2], Hacc[j][3]);
                *(LAS u32x2*)(L_H + (wr * 16 + fr) * 272 + ((4 * wc + j) * 16 + fq * 4) * 2) = o; }
        }
        __syncthreads();
#undef SSD_GC
#undef SSD_ISSUE
    }
#undef TRB
#undef TRX
}

__device__ __forceinline__ void phase_C2(const Args& a, unsigned char* ws, const int bid, int l, int wave, int lane) {
    bf16_t* z = (bf16_t*)(ws + WS_Z);
    const float* g_ssd = INP(14) + l * 2048; const float* g_mlp = INP(18) + l * 2048;
    const int gw = bid * 8 + wave, NGW = gridDim.x * 8;
    f32x4 gs[8];
#pragma unroll
    for (int j = 0; j < 4; ++j) { gs[2 * j] = *(const f32x4*)(g_ssd + j * 512 + lane * 8); gs[2 * j + 1] = *(const f32x4*)(g_ssd + j * 512 + lane * 8 + 4); }
    for (int r = gw + (l == 3 ? TCTX : 0); r < T; r += NGW) {
        bf16_t* zr = z + (size_t)r * ZW;
        const float ybr = ((const float*)(ws + WS_YBS))[r];
        float yv[32]; float ss = 0.f;
#pragma unroll
        for (int j = 0; j < 4; ++j) { const int col = j * 512 + lane * 8;
            const u32x4 yf = *(const u32x4*)(zr + col), yb = *(const u32x4*)(zr + 2048 + col), zs = *(const u32x4*)(zr + ZC_ZSSD + col);
            float f0[8], f1[8], f2[8]; unpack8(yf, f0); unpack8(yb, f1); unpack8(zs, f2);
#pragma unroll
            for (int e = 0; e < 8; ++e) { const float y = (f0[e] + f1[e]) * silu_f(f2[e]); yv[j * 8 + e] = y; ss += y * y; } }
        const float ra = rsqrtf(wave_sum(ss) * (1.f / 2048.f) + EPS) * sqrtf(ybr * (1.f / 2048.f) + EPS);
#pragma unroll
        for (int j = 0; j < 4; ++j) { const int col = j * 512 + lane * 8;
            const f32x4 g0 = gs[2 * j], g1 = gs[2 * j + 1];
            float o[8] = {yv[j * 8 + 0] * ra * g0.x, yv[j * 8 + 1] * ra * g0.y, yv[j * 8 + 2] * ra * g0.z, yv[j * 8 + 3] * ra * g0.w,
                          yv[j * 8 + 4] * ra * g1.x, yv[j * 8 + 5] * ra * g1.y, yv[j * 8 + 6] * ra * g1.z, yv[j * 8 + 7] * ra * g1.w};
            *(u32x4*)(zr + ZC_ZSSD + col) = pack8(o); }
    }
}

__global__ void __launch_bounds__(512, 2) mk_fwd(Args a) {
    extern __shared__ __attribute__((aligned(16))) unsigned char lds_raw[];
    LAS unsigned char* lds = (LAS unsigned char*)lds_raw;
    cg::grid_group grid = cg::this_grid();
    { LAS unsigned* stw = (LAS unsigned*)(lds + LDS_BAR_OFF); if (threadIdx.x < 4) stw[threadIdx.x] = 0u; }
    __syncthreads();
    (void)xcd_barrier_post((unsigned*)(a.ws + WS_BAR), (volatile LAS unsigned*)(lds + LDS_BAR_OFF));
    int ph = a.ph_lo, rep = 0, nsync = 0; bool first = true;
#ifdef SYNC_PROBE
    for (int i = 0; i < 100; ++i) { XcdBarrier xb; xb.bar = (unsigned*)(a.ws + WS_BAR); xb.x = xb_xcc_id(); xb.st = (volatile LAS unsigned*)(lds + LDS_BAR_OFF); xcd_barrier(xb); }
#endif
#pragma unroll 1
    while (ph < a.ph_hi) {
        if (!first) { if (nsync == 0) grid.sync(); else { XcdBarrier xb; xb.bar = (unsigned*)(a.ws + WS_BAR); xb.x = xb_xcc_id(); xb.st = (volatile LAS unsigned*)(lds + LDS_BAR_OFF); xcd_barrier(xb); } ++nsync; }
        first = false;
        int tid = threadIdx.x; asm volatile("" : "+v"(tid));
        int bid = blockIdx.x; asm volatile("" : "+s"(bid));
        long zo = 0; asm volatile("" : "+s"(zo)); unsigned char* ws = a.ws + zo;
        const int wave = __builtin_amdgcn_readfirstlane(tid >> 6), lane = tid & 63;
        const int l = (ph - 1) / 6, sub = (ph - 1) % 6;
        if (ph == 0) phase_prologue(a, ws, bid, lds, tid, wave, lane);
        else if (sub == 0) phase_A(a, ws, bid, l, wave, lane);
        else if (sub == 1 || sub == 5) {
            pg8::Gemm g; void* cout; int ldc, mode;
            int tail = 0; g.A2 = nullptr; g.P2 = nullptr; const float* rbs = nullptr; const float* rbs_tail = nullptr;
            if (sub == 1) { g.A = (const bf16_t*)(ws + WS_HX); g.Bt = (const bf16_t*)(ws + WS_WIN) + (size_t)l * ZW * 2048; g.M = T; g.N = ZW; g.K = 2048; g.lda = 2048; cout = ws + WS_Z; ldc = ZW; mode = 0; }
            else { const int r0 = TCTX; rbs = (const float*)(ws + WS_YBS) + r0; rbs_tail = (const float*)(ws + WS_YBS);
                if (l < 3) { tail = 1; g.A2 = (const bf16_t*)(ws + WS_Z) + 4096; g.P2 = (float*)(ws + WS_XBC); }
                g.A = (const bf16_t*)(ws + WS_Z) + (size_t)r0 * ZW + 4096; g.Bt = (const bf16_t*)(ws + WS_WOUT) + (size_t)l * 2048 * 4096; g.M = T - r0; g.N = 2048; g.K = 4096; g.lda = ZW;
                cout = (bf16_t*)(ws + WS_Z) + (size_t)r0 * ZW; ldc = ZW; mode = 0; }
            pg8::StaticOrder S; S.init(g.M, g.N, (int)gridDim.x, bid, tail);
            pg8::gemm_phase(tid, lds, g, S, mode, cout, ldc, sub == 1 ? (float*)(ws + WS_RVS) : (float*)nullptr, rbs, rbs_tail);
            if (sub == 1 && l < 3) {
                const int nlong = (ZW / 256) * (T / 256) - ((ZW / 256) * (T / 256) / (int)gridDim.x) * (int)gridDim.x, G_ = (int)gridDim.x;
                if (nlong > 0 && nlong < G_) { if (bid >= nlong) convert_layer_weights(a, ws, l + 1, (bid - nlong) * 8 + wave, (G_ - nlong) * 8, lds, wave, lane); }
                else convert_layer_weights(a, ws, l + 1, bid * 8 + wave, G_ * 8, lds, wave, lane);
            }
        }
        else if (sub == 2) phase_C0(a, ws, bid, l, lds, tid, wave, lane);
        else if (sub == 3) phase_C1(a, ws, bid, l, lds, tid, wave, lane);
        else phase_C2(a, ws, bid, l, wave, lane);
        const int reps = ((ph > 0 && ((REP_MASK >> sub) & 1)) || (ph == 0 && (REP_MASK & 64)) || (ph > 0 && sub == 0 && l <= 1 && (REP_MASK & 128))) ? 2 : 1;
        if (++rep >= reps) { rep = 0; ++ph; }
    }
}

extern "C" void kernel_launch(void* const* d_in, const int* in_sizes, int n_in, void* d_out, int out_size, void* d_ws, size_t ws_size, hipStream_t stream) {
    static int grid = 0;
    if (grid == 0) {
        if (n_in != 20 || ws_size < WS_END) { fprintf(stderr, "kernel_launch: need 20 inputs and %zu bytes of workspace (got %d, %zu)\n", (size_t)WS_END, n_in, ws_size); grid = -1; return; }
        int dev = 0, cus = 0, per_cu = 0;
        hipGetDevice(&dev);
        hipDeviceGetAttribute(&cus, hipDeviceAttributeMultiprocessorCount, dev);
        hipFuncSetAttribute((const void*)mk_fwd, hipFuncAttributeMaxDynamicSharedMemorySize, LDS_BYTES);
        if (hipOccupancyMaxActiveBlocksPerMultiprocessor(&per_cu, (const void*)mk_fwd, 512, LDS_BYTES) != hipSuccess || per_cu < 1) per_cu = 1;
        (void)hipGetLastError();
        grid = cus * per_cu;
    }
    if (grid < 0) return;
    Args a{};
    for (int i = 0; i < 20; ++i) a.in[i] = (const float*)d_in[i];
    a.out = (float*)d_out; a.ws = (unsigned char*)d_ws; a.ph_lo = 0; a.ph_hi = 26;
    if (hipMemsetAsync((char*)d_ws + WS_BAR, 0, XCD_BAR_WORDS * sizeof(unsigned), stream) != hipSuccess) { fprintf(stderr, "kernel_launch: memset of the barrier words failed\n"); return; }
    void* args[] = {&a};
    hipError_t e = hipLaunchCooperativeKernel((const void*)mk_fwd, dim3(grid), dim3(512), args, LDS_BYTES, stream);
    if (e != hipSuccess) fprintf(stderr, "cooperative launch failed: %s (grid %d)\n", hipGetErrorString(e), grid);
}
```

```cpp
#include <hip/hip_runtime.h>
#include <hip/hip_cooperative_groups.h>
#include <cstdio>
#include <cstdint>
namespace cg = cooperative_groups;

#define LAS __attribute__((address_space(3)))
typedef unsigned short bf16_t;
typedef short bf16x8 __attribute__((ext_vector_type(8)));
typedef float f32x4 __attribute__((ext_vector_type(4)));
typedef float f32x2 __attribute__((ext_vector_type(2)));
typedef unsigned u32x4 __attribute__((ext_vector_type(4)));
typedef unsigned u32x2 __attribute__((ext_vector_type(2)));

constexpr int D = 2048, NB = 4, SEQ = 8192, DEPTH = 4, CTXL = 256;
constexpr int TCTX = NB * CTXL;
constexpr int T = TCTX + NB * SEQ;
constexpr int NCH = T / 128;
constexpr int ZW = 12544;
constexpr int ZC_ZSSD = 4096, ZC_U = 6144, ZC_V = 8192, ZC_ZMLP = 10240, ZC_DT = 12288;
constexpr int INW = 12352;
constexpr float EPS = 1e-6f;
constexpr int LDS_BAR_OFF = 161280;
constexpr int LDS_BYTES = 161296;
#ifndef REP_MASK
#define REP_MASK 0
#endif

constexpr size_t WS_BAR = 0;
constexpr size_t WS_MOD = 16384;
constexpr size_t WS_WSB = WS_MOD + 491520;
constexpr size_t WS_RVS = WS_WSB + 2097152;
constexpr size_t WS_YBS = WS_RVS + (size_t)T * 4;
constexpr size_t WS_DT = WS_YBS + (size_t)T * 4;
constexpr size_t WS_CTX = WS_DT + (size_t)T * 64 * 4;
constexpr size_t WS_WIN = WS_CTX + (size_t)TCTX * D * 4;
constexpr size_t WS_WOUT = WS_WIN + (size_t)4 * ZW * D * 2;
constexpr size_t WS_HX = WS_WOUT + (size_t)4 * 2048 * 4096 * 2;
constexpr size_t WS_Z = WS_HX + (size_t)T * D * 2;
constexpr size_t WS_XBC = WS_Z + (size_t)T * ZW * 2;
constexpr size_t WS_END = WS_XBC + (size_t)T * 4096 * 2;

struct Args { const float* in[20]; float* out; unsigned char* ws; int ph_lo, ph_hi; };

__device__ __forceinline__ unsigned cvt_pk_bf16(float lo, float hi) { unsigned r; asm volatile("v_cvt_pk_bf16_f32 %0, %1, %2" : "=v"(r) : "v"(lo), "v"(hi)); return r; }
__device__ __forceinline__ float bflo(unsigned u) { return __builtin_bit_cast(float, u << 16); }
__device__ __forceinline__ float bfhi(unsigned u) { return __builtin_bit_cast(float, u & 0xffff0000u); }
__device__ __forceinline__ float bf1(bf16_t h) { return __builtin_bit_cast(float, ((unsigned)h) << 16); }
template <int CTRL, int ROWMASK> __device__ __forceinline__ float dpp_get0(float v) { return __builtin_bit_cast(float, __builtin_amdgcn_update_dpp(0, __builtin_bit_cast(int, v), CTRL, ROWMASK, 0xf, true)); }
__device__ __forceinline__ float wave_incl_scan(float v) {
    v += dpp_get0<0x111, 0xf>(v); v += dpp_get0<0x112, 0xf>(v); v += dpp_get0<0x114, 0xf>(v); v += dpp_get0<0x118, 0xf>(v);
    v += dpp_get0<0x142, 0xa>(v);
    v += dpp_get0<0x143, 0xc>(v);
    return v;
}
__device__ __forceinline__ float wave_sum(float v) {
    return __builtin_bit_cast(float, __builtin_amdgcn_readlane(__builtin_bit_cast(int, wave_incl_scan(v)), 63));
}
__device__ __forceinline__ float silu_f(float x) { return x * __builtin_amdgcn_rcpf(1.f + __expf(-x)); }
__device__ __forceinline__ void unpack8(const u32x4 v, float* f) {
    f[0] = bflo(v.x); f[1] = bfhi(v.x); f[2] = bflo(v.y); f[3] = bfhi(v.y); f[4] = bflo(v.z); f[5] = bfhi(v.z); f[6] = bflo(v.w); f[7] = bfhi(v.w);
}
__device__ __forceinline__ u32x4 pack8(const float* f) {
    u32x4 w; w.x = cvt_pk_bf16(f[0], f[1]); w.y = cvt_pk_bf16(f[2], f[3]); w.z = cvt_pk_bf16(f[4], f[5]); w.w = cvt_pk_bf16(f[6], f[7]); return w;
}
__device__ __forceinline__ const float* inp_(const float* p) { long zo = 0; asm volatile("" : "+s"(zo)); return p + zo; }
#define INP(k) inp_(a.in[k])
typedef short s16x4 __attribute__((ext_vector_type(4)));
__device__ __forceinline__ bf16x8 ldfrag_tr(LAS const unsigned char* base, const int pitch, const int krow0, const int col0, const int lane) {
    const int g = lane >> 4, q = (lane & 15) >> 2, p = lane & 3;
    LAS const unsigned char* a0 = base + (krow0 + 8 * g + q) * pitch + (col0 + 4 * p) * 2;
    const s16x4 lo = __builtin_amdgcn_ds_read_tr16_b64_v4i16((LAS s16x4*)a0);
    const s16x4 hi = __builtin_amdgcn_ds_read_tr16_b64_v4i16((LAS s16x4*)(a0 + 4 * pitch));
    return (bf16x8){lo.x, lo.y, lo.z, lo.w, hi.x, hi.y, hi.z, hi.w};
}
__device__ __forceinline__ int offb(const int row, const int ch) { return 256 * row + 16 * (ch ^ (((row & 3) << 2) | ((row >> 2) & 3))); }
__device__ __forceinline__ int offx(const int row, const int ch) { return 128 * row + 16 * (ch ^ ((((row >> 1) & 1) << 1) | (((row >> 3) & 1) << 2))); }
__device__ __forceinline__ bf16x8 ldfrag_tr_b(LAS const unsigned char* base, const int krow0, const int c, const int lane) {
    const int g = lane >> 4, q = (lane & 15) >> 2, p = lane & 3, row = krow0 + 8 * g + q;
    const s16x4 lo = __builtin_amdgcn_ds_read_tr16_b64_v4i16((LAS s16x4*)(base + offb(row, 2 * c + (p >> 1)) + 8 * (p & 1)));
    const s16x4 hi = __builtin_amdgcn_ds_read_tr16_b64_v4i16((LAS s16x4*)(base + offb(row + 4, 2 * c + (p >> 1)) + 8 * (p & 1)));
    return (bf16x8){lo.x, lo.y, lo.z, lo.w, hi.x, hi.y, hi.z, hi.w};
}
__device__ __forceinline__ bf16x8 ldfrag_tr_bp(LAS const unsigned char* base, const int krow0, const int c, const int lane) {
    const int g = lane >> 4, q = (lane & 15) >> 2, p = lane & 3, row = krow0 + 8 * g + q, ch = 4 * (c >> 1) + p, b8 = 8 * (c & 1);
    const s16x4 lo = __builtin_amdgcn_ds_read_tr16_b64_v4i16((LAS s16x4*)(base + offb(row, ch) + b8));
    const s16x4 hi = __builtin_amdgcn_ds_read_tr16_b64_v4i16((LAS s16x4*)(base + offb(row + 4, ch) + b8));
    return (bf16x8){lo.x, lo.y, lo.z, lo.w, hi.x, hi.y, hi.z, hi.w};
}
__device__ __forceinline__ bf16x8 ldfrag_tr_x(LAS const unsigned char* base, const int krow0, const int c, const int lane) {
    const int g = lane >> 4, q = (lane & 15) >> 2, p = lane & 3, row = krow0 + 8 * g + q;
    LAS const unsigned char* a0 = base + offx(row, 2 * c + (p >> 1)) + 8 * (p & 1);
    const s16x4 lo = __builtin_amdgcn_ds_read_tr16_b64_v4i16((LAS s16x4*)a0);
    const s16x4 hi = __builtin_amdgcn_ds_read_tr16_b64_v4i16((LAS s16x4*)(a0 + 512));
    return (bf16x8){lo.x, lo.y, lo.z, lo.w, hi.x, hi.y, hi.z, hi.w};
}
#define LDS_BARRIER() do { asm volatile("s_waitcnt lgkmcnt(0)" ::: "memory"); __builtin_amdgcn_s_barrier(); asm volatile("" ::: "memory"); } while (0)
#define MFMA16(a, b, c) __builtin_amdgcn_mfma_f32_16x16x32_bf16((a), (b), (c), 0, 0, 0)

namespace pg8 {
constexpr int BM = 256, BK = 64, HALF = 128, HTB = HALF * BK * 2, STAGE_BYTES = 8 * HTB, NXCD = 8, WGM = 8;
__device__ __forceinline__ int lds_byte(int r, int c) { const int st = (r >> 4) * 2 + (c >> 5), rr = r & 15, cc = c & 31, ob = rr * 64 + cc * 2; return st * 1024 + (ob ^ (((ob >> 9) & 1) << 5)); }
__device__ __forceinline__ void stage_rc(int b, int& R, int& C) { const int st = b / 1024, sb = b % 1024, swz = sb ^ (((sb >> 9) & 1) << 5); R = (st >> 1) * 16 + swz / 64; C = (st & 1) * 32 + (swz % 64) / 2; }
__device__ __forceinline__ int perm32(int rho) { const int n = rho >> 4, i = rho & 15; return 8 * (i >> 2) + 4 * n + (i & 3); }
struct Unit { int pm, pn, kc; };
struct Gemm { const bf16_t* A; const bf16_t* Bt; int M, N, K, lda; const bf16_t* A2; float* P2; };
struct StaticOrder {
    int nM, nN, nwg, G, c, tail;
    __device__ void init(int M, int N, int G_, int c_, int tail_) { nM = M / BM; nN = N / BM; nwg = nM * nN; G = G_; c = c_; tail = tail_; }
    __device__ bool next(int i, Unit& u) const {
        const long L = (long)i * G + c;
        if (L >= nwg) { const long t = L - nwg; if (!tail || t >= 256) return false; u.pm = (int)(t >> 6); u.pn = (int)(t >> 3) & 7; u.kc = (int)t & 7; return true; }
        u.kc = -1;
        int wgid = (int)L; { const int q = nwg / NXCD, r = nwg % NXCD, xcd = wgid % NXCD, off = wgid / NXCD; wgid = (xcd < r ? xcd * (q + 1) : r * (q + 1) + (xcd - r) * q) + off; }
        const int nig = WGM * nN, gid = wgid / nig, fm = gid * WGM, gsz = (nM - fm) < WGM ? (nM - fm) : WGM;
        u.pm = fm + ((wgid % nig) % gsz); u.pn = (wgid % nig) / gsz; return true;
    }
};
struct EpiF32 {
    static constexpr bool PERM = false;
    float* C; int ldc;
    __device__ __forceinline__ void operator()(const f32x4 (&acc)[2][2][4][2], const Unit& u, int wr, int wc, int fr, int fq) const {
        const int row0 = u.pm * BM + wr * 64 + fr, col0 = u.pn * BM + wc * 32 + 4 * fq;
#pragma unroll
        for (int ai = 0; ai < 2; ++ai)
#pragma unroll
            for (int m = 0; m < 4; ++m) { float* rowp = C + (size_t)(row0 + ai * HALF + m * 16) * ldc + col0;
#pragma unroll
                for (int bj = 0; bj < 2; ++bj)
#pragma unroll
                    for (int n = 0; n < 2; ++n) *(f32x4*)(rowp + bj * HALF + n * 16) = acc[ai][bj][m][n]; }
    }
};
struct EpiF32Perm {
    float* C; int ldc;
    __device__ __forceinline__ void operator()(const f32x4 (&acc)[2][2][4][2], const Unit& u, int wr, int wc, int fr, int fq) const {
        const int row0 = u.pm * BM + wr * 64 + fr, col0 = u.pn * BM + wc * 32 + 8 * fq;
#pragma unroll
        for (int ai = 0; ai < 2; ++ai)
#pragma unroll
            for (int m = 0; m < 4; ++m) { float* rowp = C + (size_t)(row0 + ai * HALF + m * 16) * ldc + col0;
#pragma unroll
                for (int bj = 0; bj < 2; ++bj) { *(f32x4*)(rowp + bj * HALF) = acc[ai][bj][m][0]; *(f32x4*)(rowp + bj * HALF + 4) = acc[ai][bj][m][1]; } }
    }
};
struct EpiBf16 {
    static constexpr bool PERM = true;
    bf16_t* O; int ldc;
    __device__ __forceinline__ void operator()(const f32x4 (&acc)[2][2][4][2], const Unit& u, int wr, int wc, int fr, int fq) const {
        const int row0 = u.pm * BM + wr * 64 + fr, col0 = u.pn * BM + wc * 32 + 8 * fq;
#pragma unroll
        for (int ai = 0; ai < 2; ++ai)
#pragma unroll
            for (int m = 0; m < 4; ++m) { bf16_t* rowp = O + (size_t)(row0 + ai * HALF + m * 16) * ldc + col0;
#pragma unroll
                for (int bj = 0; bj < 2; ++bj) { const f32x4 v0 = acc[ai][bj][m][0], v1 = acc[ai][bj][m][1];
                    u32x4 w; w.x = cvt_pk_bf16(v0[0], v0[1]); w.y = cvt_pk_bf16(v0[2], v0[3]); w.z = cvt_pk_bf16(v1[0], v1[1]); w.w = cvt_pk_bf16(v1[2], v1[3]);
                    __builtin_nontemporal_store(w, (u32x4*)(rowp + bj * HALF)); } }
    }
};

__device__ __forceinline__ void gemm_phase(const int tid, LAS unsigned char* lds, const Gemm g, const StaticOrder& S, const int mode  , void* Cout, const int ldc, float* rvs, const float* rbs, const float* rbs_tail) {
    const int wid = __builtin_amdgcn_readfirstlane(tid >> 6), lane = tid & 63, wr = wid >> 2, wc = wid & 3, fr = lane & 15, fq = lane >> 4;
    const int K = g.K, nt = K / BK, lda = g.lda;
    unsigned voffA[2], voffB[2];
#pragma unroll
    for (int i = 0; i < 2; ++i) { int R, C; stage_rc(tid * 16 + i * 8192, R, C); const int Rb = (mode == 0) ? ((R & ~31) + perm32(R & 31)) : R;
        voffA[i] = (unsigned)(R * lda + C) * 2u; voffB[i] = (unsigned)(Rb * K + C) * 2u; }
    const size_t kstep = (size_t)(BK * 2);
    const size_t hstepA = (size_t)HALF * lda * 2, hstepB = (size_t)HALF * K * 2;
    const size_t tstepA = 2 * hstepA, tstepB = 2 * hstepB;
    const unsigned ldsw = (unsigned)wid * 1024u;
    const int aoff = lds_byte(wr * 64 + fr, fq * 8), boff = lds_byte(wc * 32 + fr, fq * 8);
#define PG8_SA(b, h) (((b) * 2 + (h)) * HTB)
#define PG8_SB(b, h) ((4 + (b) * 2 + (h)) * HTB)
#define PG8_STAGE(bufoff, gbase, voff) do { _Pragma("unroll") for (int _i = 0; _i < 2; ++_i) \
        __builtin_amdgcn_global_load_lds((const unsigned*)((const char*)(gbase) + (voff)[_i]), (LAS unsigned*)(lds + (bufoff) + ldsw + _i * 8192), 16, 0, 0); } while (0)
#define PG8_LDA(dst, b, h) do { _Pragma("unroll") for (int m = 0; m < 4; ++m) _Pragma("unroll") for (int k = 0; k < 2; ++k) dst[m][k] = *(const LAS bf16x8*)(lds + PG8_SA(b, h) + aoff + m * 2048 + k * 1024); } while (0)
#define PG8_LDB(dst, b, h) do { _Pragma("unroll") for (int n = 0; n < 2; ++n) _Pragma("unroll") for (int k = 0; k < 2; ++k) dst[n][k] = *(const LAS bf16x8*)(lds + PG8_SB(b, h) + boff + n * 2048 + k * 1024); } while (0)
#define PG8_MMA(ai, bj, At, Bt) do { __builtin_amdgcn_s_setprio(1); _Pragma("unroll") for (int m = 0; m < 4; ++m) _Pragma("unroll") for (int n = 0; n < 2; ++n) _Pragma("unroll") for (int k = 0; k < 2; ++k) \
        acc[ai][bj][m][n] = __builtin_amdgcn_mfma_f32_16x16x32_bf16(Bt[n][k], At[m][k], acc[ai][bj][m][n], 0, 0, 0); __builtin_amdgcn_s_setprio(0); } while (0)
#define PG8_WAIT_V(n) asm volatile("s_waitcnt vmcnt(" #n ")" ::: "memory")
#define PG8_WAIT_L(n) asm volatile("s_waitcnt lgkmcnt(" #n ")" ::: "memory")
#define PG8_BAR __builtin_amdgcn_s_barrier()
#define PG8_SCHED __builtin_amdgcn_sched_barrier(0)
    Unit cur, nxt; int ui = 0;
    if (!S.next(0, cur)) return;
    f32x4 acc[2][2][4][2];
#pragma unroll
    for (int a = 0; a < 2; ++a)
#pragma unroll
        for (int b = 0; b < 2; ++b)
#pragma unroll
            for (int m = 0; m < 4; ++m)
#pragma unroll
                for (int n = 0; n < 2; ++n) acc[a][b][m][n] = (f32x4){0.f, 0.f, 0.f, 0.f};
    bf16x8 At[4][2], B0[2][2], B1[2][2];
#define PG8_UA(u) ((u).kc < 0 ? (const char*)g.A + (size_t)(u).pm * tstepA : (const char*)g.A2 + (size_t)(u).pm * tstepA + (size_t)(u).kc * 1024)
#define PG8_UB(u) ((const char*)g.Bt + (size_t)(u).pn * tstepB + ((u).kc < 0 ? (size_t)0 : (size_t)(u).kc * 1024))
    const char* cA = PG8_UA(cur); const char* cB = PG8_UB(cur);
    PG8_STAGE(PG8_SB(0, 0), cB, voffB); PG8_STAGE(PG8_SB(0, 1), cB + hstepB, voffB); PG8_STAGE(PG8_SA(0, 0), cA, voffA); PG8_STAGE(PG8_SA(0, 1), cA + hstepA, voffA);
    if (wr == 1) PG8_BAR;
    PG8_WAIT_V(2); PG8_BAR;
    PG8_STAGE(PG8_SB(1, 0), cB + kstep, voffB); PG8_STAGE(PG8_SA(1, 0), cA + kstep, voffA); PG8_STAGE(PG8_SB(1, 1), cB + hstepB + kstep, voffB);
    PG8_WAIT_V(6); PG8_BAR;
    for (;;) {
        const bool has_next = S.next(ui + 1, nxt);
        const char* nA = has_next ? PG8_UA(nxt) : cA; const char* nB = has_next ? PG8_UB(nxt) : cB;
        const int ntu = cur.kc < 0 ? nt : 8;
        for (int t = 0; t < ntu; t += 2) {
            const bool last = (t == ntu - 2);
            const char* a1 = cA + (size_t)(t + 1) * kstep;
            const char* a2 = last ? nA : cA + (size_t)(t + 2) * kstep; const char* b2 = last ? nB : cB + (size_t)(t + 2) * kstep;
            const char* a3 = a2 + kstep; const char* b3 = b2 + kstep;
            PG8_LDB(B0, 0, 0); PG8_LDB(B1, 0, 1); PG8_SCHED; PG8_LDA(At, 0, 0); PG8_STAGE(PG8_SA(1, 1), a1 + hstepA, voffA);
            PG8_WAIT_V(8); PG8_WAIT_L(0); PG8_BAR; PG8_MMA(0, 0, At, B0); PG8_MMA(0, 1, At, B1); PG8_BAR; PG8_SCHED;
            PG8_LDA(At, 0, 1); PG8_STAGE(PG8_SB(0, 0), b2, voffB); PG8_STAGE(PG8_SB(0, 1), b2 + hstepB, voffB); PG8_STAGE(PG8_SA(0, 0), a2, voffA);
            PG8_WAIT_V(8); PG8_WAIT_L(0); PG8_BAR; PG8_MMA(1, 0, At, B0); PG8_MMA(1, 1, At, B1); PG8_BAR; PG8_SCHED;
            PG8_LDB(B0, 1, 0); PG8_LDB(B1, 1, 1); PG8_SCHED; PG8_LDA(At, 1, 0); PG8_STAGE(PG8_SA(0, 1), a2 + hstepA, voffA);
            PG8_WAIT_V(8); PG8_WAIT_L(0); PG8_BAR; PG8_MMA(0, 0, At, B0); PG8_MMA(0, 1, At, B1); PG8_BAR; PG8_SCHED;
            PG8_LDA(At, 1, 1); PG8_STAGE(PG8_SB(1, 0), b3, voffB); PG8_STAGE(PG8_SB(1, 1), b3 + hstepB, voffB); PG8_STAGE(PG8_SA(1, 0), a3, voffA);
            PG8_WAIT_V(8); PG8_WAIT_L(0); PG8_BAR; PG8_MMA(1, 0, At, B0); PG8_MMA(1, 1, At, B1); PG8_BAR; PG8_SCHED;
        }
        if (wr == 0) PG8_BAR;
        { const float* rp = cur.kc >= 0 ? rbs_tail : rbs;
          if (rp != nullptr) {
#pragma unroll
            for (int ai = 0; ai < 2; ++ai)
#pragma unroll
                for (int m = 0; m < 4; ++m) { const float rb = rsqrtf(rp[cur.pm * BM + ai * HALF + wr * 64 + m * 16 + fr] * (1.f / 2048.f) + EPS);
#pragma unroll
                    for (int bj = 0; bj < 2; ++bj)
#pragma unroll
                        for (int n = 0; n < 2; ++n) acc[ai][bj][m][n] = acc[ai][bj][m][n] * rb; } } }
        if (cur.kc >= 0) { EpiF32Perm E; E.C = g.P2 + (size_t)cur.kc * TCTX * 2048; E.ldc = 2048; E(acc, cur, wr, wc, fr, fq); }
        else if (mode == 0 && rvs != nullptr && ((cur.pn >= 24 && cur.pn < 32) || (cur.pn >= 40 && cur.pn < 48))) {
            const int j = cur.pn < 32 ? cur.pn - 24 : cur.pn - 32;
            bf16_t* O = (bf16_t*)Cout + ZC_U + 128 * j + wc * 32 + 8 * fq; const int row0 = cur.pm * BM + wr * 64 + fr;
#pragma unroll
            for (int ai = 0; ai < 2; ++ai)
#pragma unroll
                for (int m = 0; m < 4; ++m) { const f32x4 u0 = acc[ai][0][m][0], u1 = acc[ai][0][m][1], z0 = acc[ai][1][m][0], z1 = acc[ai][1][m][1];
                    u32x4 w; w.x = cvt_pk_bf16(u0[0] * silu_f(z0[0]), u0[1] * silu_f(z0[1])); w.y = cvt_pk_bf16(u0[2] * silu_f(z0[2]), u0[3] * silu_f(z0[3]));
                    w.z = cvt_pk_bf16(u1[0] * silu_f(z1[0]), u1[1] * silu_f(z1[1])); w.w = cvt_pk_bf16(u1[2] * silu_f(z1[2]), u1[3] * silu_f(z1[3]));
                    __builtin_nontemporal_store(w, (u32x4*)(O + (size_t)(row0 + ai * HALF + m * 16) * ldc)); } }
        else if (mode == 0) { EpiBf16 E; E.O = (bf16_t*)Cout; E.ldc = ldc; E(acc, cur, wr, wc, fr, fq);
            if (rvs != nullptr && (cur.pn >> 3) == 4) {
#pragma unroll
                for (int ai = 0; ai < 2; ++ai)
#pragma unroll
                    for (int m = 0; m < 4; ++m) { float ss = 0.f;
#pragma unroll
                        for (int bj = 0; bj < 2; ++bj)
#pragma unroll
                            for (int n = 0; n < 2; ++n) { const f32x4 v = acc[ai][bj][m][n]; ss += (v.x * v.x + v.y * v.y) + (v.z * v.z + v.w * v.w); }
                        ss += __shfl_xor(ss, 16); ss += __shfl_xor(ss, 32);
                        if (fq == 0) unsafeAtomicAdd(rvs + cur.pm * BM + ai * HALF + wr * 64 + m * 16 + fr, ss); } } }
        else { EpiF32 E; E.C = (float*)Cout; E.ldc = ldc; E(acc, cur, wr, wc, fr, fq); }
        if (!has_next) break;
#pragma unroll
        for (int a = 0; a < 2; ++a)
#pragma unroll
            for (int b = 0; b < 2; ++b)
#pragma unroll
                for (int m = 0; m < 4; ++m)
#pragma unroll
                    for (int n = 0; n < 2; ++n) acc[a][b][m][n] = (f32x4){0.f, 0.f, 0.f, 0.f};
        cur = nxt; cA = nA; cB = nB; ++ui;
        if (wr == 1) PG8_BAR;
    }
    PG8_WAIT_V(0);
    PG8_BAR;
#undef PG8_UA
#undef PG8_UB
#undef PG8_SA
#undef PG8_SB
#undef PG8_STAGE
#undef PG8_LDA
#undef PG8_LDB
#undef PG8_MMA
#undef PG8_WAIT_V
#undef PG8_WAIT_L
#undef PG8_BAR
#undef PG8_SCHED
}
}

#define XB_TMO      128
#define XB_XCNT(j)  (256  + 64 * (j))
#define XB_XSUB(j)  (1280 + 64 * (j))
#define XB_XGEN(j)  (2304 + 64 * (j))
#define XB_TOP      3328
#define XB_TOPGEN   3392
#define XCD_BAR_WORDS 3456
#define XB_SPIN_CAP (1u << 18)

__device__ __forceinline__ unsigned xb_ld(unsigned* p)              { return __hip_atomic_load(p, __ATOMIC_RELAXED, __HIP_MEMORY_SCOPE_AGENT); }
__device__ __forceinline__ unsigned xb_add(unsigned* p, unsigned v) { return __hip_atomic_fetch_add(p, v, __ATOMIC_RELAXED, __HIP_MEMORY_SCOPE_AGENT); }
__device__ __forceinline__ unsigned xb_xcc_id() { return (unsigned)__builtin_amdgcn_s_getreg((3 << 11) | 20) & 0xFu; }
#define XB_SPIN(cond, bar) do { unsigned _sp = 0; while (cond) { __builtin_amdgcn_s_sleep(1); \
    if ((++_sp & 255u) == 0u) { if (xb_ld(&(bar)[XB_TMO])) break; if (_sp > XB_SPIN_CAP) { atomicAdd(&(bar)[XB_TMO], 1u); break; } } } } while (0)

struct XcdBarrier {
    unsigned* bar; unsigned x;
    volatile LAS unsigned* st;
};

__device__ __forceinline__ XcdBarrier xcd_barrier_post(unsigned* bar, volatile LAS unsigned* st) {
    XcdBarrier b; b.bar = bar; b.x = xb_xcc_id(); b.st = st;
    if (threadIdx.x == 0) (void)xb_add(&bar[XB_XCNT(b.x)], 1u);
    return b;
}
__device__ __forceinline__ void xcd_barrier_complete(unsigned* bar, unsigned x, unsigned& nloc, unsigned& nx) {
    const unsigned G = gridDim.x * gridDim.y * gridDim.z;
    unsigned sum, cnt, mine, sp = 0u;
    for (;;) {
        sum = 0u; cnt = 0u; mine = 0u;
#pragma unroll
        for (unsigned j = 0; j < 16; ++j) { const unsigned c = xb_ld(&bar[XB_XCNT(j)]); sum += c; cnt += (c > 0u) ? 1u : 0u; mine = (j == x) ? c : mine; }
        if (sum == G) break;
        __builtin_amdgcn_s_sleep(1);
        if ((++sp & 255u) == 0u) { if (xb_ld(&bar[XB_TMO])) break; if (sp > XB_SPIN_CAP) { atomicAdd(&bar[XB_TMO], 1u); break; } }
    }
    nloc = mine > 0u ? mine : 1u; nx = cnt > 0u ? cnt : 1u;
}

__device__ __forceinline__ void xcd_barrier(const XcdBarrier& b) {
    asm volatile("s_waitcnt vmcnt(0)" ::: "memory");
    __syncthreads();
    if (threadIdx.x == 0) {
        unsigned* bar = b.bar;
        __builtin_amdgcn_s_waitcnt(0);
        unsigned nloc = b.st[0], nx = b.st[1];
        if (nloc == 0u) { xcd_barrier_complete(bar, b.x, nloc, nx); b.st[0] = nloc; b.st[1] = nx; }
        const unsigned old = xb_add(&bar[XB_XSUB(b.x)], 1u);
        const unsigned gen = old / nloc;
        if (old + 1u == (gen + 1u) * nloc) {
            __builtin_amdgcn_fence(__ATOMIC_RELEASE, "agent");
            asm volatile("s_waitcnt vmcnt(0)" ::: "memory");
            const unsigned og = xb_add(&bar[XB_TOP], 1u);
            const unsigned tg = og / nx;
            if (og + 1u == (tg + 1u) * nx) xb_add(&bar[XB_TOPGEN], 1u);
            else XB_SPIN(xb_ld(&bar[XB_TOPGEN]) == tg, bar);
            __builtin_amdgcn_fence(__ATOMIC_ACQUIRE, "agent");
            xb_add(&bar[XB_XGEN(b.x)], 1u);
            asm volatile("s_waitcnt vmcnt(0)" ::: "memory");
        } else {
            XB_SPIN(xb_ld(&bar[XB_XGEN(b.x)]) == gen, bar);
            __builtin_amdgcn_fence(__ATOMIC_ACQUIRE, "agent");
            asm volatile("s_waitcnt vmcnt(0)" ::: "memory");
        }
    }
    __syncthreads();
}


__device__ __forceinline__ void transpose_item(const float* W, int ldw, int srcc0, int k0, bf16_t* WT, int ldk, int n0, bool zero, LAS float* scr, int lane, const float* kscale = nullptr) {
    if (!zero) {
        f32x4 v[8];
#pragma unroll
        for (int i = 0; i < 8; ++i) { const int kk = (lane >> 3) + 8 * i; v[i] = *(const f32x4*)(W + (size_t)(k0 + kk) * ldw + srcc0 + (lane & 7) * 4); }
#pragma unroll
        for (int i = 0; i < 8; ++i) { const int kk = (lane >> 3) + 8 * i; LAS float* d = scr + kk * 33 + (lane & 7) * 4; const float sc = kscale ? kscale[kk] : 1.f; d[0] = v[i].x * sc; d[1] = v[i].y * sc; d[2] = v[i].z * sc; d[3] = v[i].w * sc; }
    }
    asm volatile("s_waitcnt lgkmcnt(0)" ::: "memory");
    const int c = lane & 7;
#pragma unroll
    for (int j = 0; j < 4; ++j) { const int n = (lane >> 3) + 8 * j; const LAS float* s = scr + (8 * c) * 33 + n;
        u32x4 o;
        if (zero) { o = (u32x4){0u, 0u, 0u, 0u}; }
        else { o.x = cvt_pk_bf16(s[0 * 33], s[1 * 33]); o.y = cvt_pk_bf16(s[2 * 33], s[3 * 33]); o.z = cvt_pk_bf16(s[4 * 33], s[5 * 33]); o.w = cvt_pk_bf16(s[6 * 33], s[7 * 33]); }
        *(u32x4*)(WT + (size_t)(n0 + n) * ldk + k0 + 8 * c) = o; }
    asm volatile("s_waitcnt lgkmcnt(0)" ::: "memory");
}

__device__ __forceinline__ void convert_layer_weights(const Args& a, unsigned char* ws, const int l, const int gw, const int NGW, LAS unsigned char* lds, const int wave, const int lane) {
    LAS float* scr = (LAS float*)(lds + wave * 16384);
    constexpr int I_IN = 32 * 392, I_OUT = 64 * 64;
    bf16_t* WinT = (bf16_t*)(ws + WS_WIN); bf16_t* WoutT = (bf16_t*)(ws + WS_WOUT);
    for (int it = gw; it < I_IN + I_OUT; it += NGW) {
        if (it < I_IN) {
            const int kb = it / 392, nb = it % 392, n0 = nb * 32;
            int src; bool zero = false;
            if (n0 < 4096) src = n0; else if (n0 < 6144) src = 4160 + (n0 - 4096);
            else if (n0 < 8192 || (n0 >= 10240 && n0 < 12288)) {
                const int rel = n0 < 8192 ? n0 - 6144 : n0 - 10240 + 2048, j = rel >> 8, cc = rel & 255; src = cc < 128 ? 6208 + 128 * j + cc : 10304 + 128 * j + (cc - 128); }
            else if (n0 < 10240) src = 8256 + (n0 - 8192); else if (n0 < 12352) src = 4096 + (n0 - 12288); else { src = 0; zero = true; }
            transpose_item(INP(8) + (size_t)l * 2048 * INW, INW, src, kb * 64, WinT + (size_t)l * ZW * 2048, 2048, n0, zero, scr, lane);
        } else {
            const int r = it - I_IN, kb = r / 64, nb = r % 64;
            transpose_item(INP(19) + (size_t)l * 4096 * 2048, 2048, nb * 32, kb * 64, WoutT + (size_t)l * 2048 * 4096, 4096, nb * 32, false, scr, lane, kb >= 32 ? INP(18) + l * 2048 + (kb * 64 - 2048) : (const float*)nullptr);
        }
    }
}

__device__ __forceinline__ void phase_prologue(const Args& a, unsigned char* ws, const int bid, LAS unsigned char* lds, int tid, int wave, int lane) {
    const int G = gridDim.x;
    {
        LAS float* sc = (LAS float*)lds;
        LAS float* part = (LAS float*)(lds + 40960);
        const float* c = INP(1); const float* cctx = INP(3);
        for (int i = tid; i < 5 * 2048; i += 512) { const int s = i >> 11, k = i & 2047; const float cv = s < 4 ? c[s * 2048 + k] : cctx[k]; sc[i] = silu_f(cv); }
        __syncthreads();
        float* mod = (float*)(ws + WS_MOD);
        for (int item = bid; item < 192; item += G) {
            const int l = item / 48, cb = item % 48, col0 = cb * 128;
            const float* W = INP(4) + (size_t)l * 2048 * 6144 + col0 + lane * 2;
            float acc[5][2];
#pragma unroll
            for (int s = 0; s < 5; ++s) { acc[s][0] = 0.f; acc[s][1] = 0.f; }
            const int k0 = wave * 256;
#pragma unroll 8
            for (int k = k0; k < k0 + 256; ++k) { const f32x2 w = *(const f32x2*)(W + (size_t)k * 6144);
#pragma unroll
                for (int s = 0; s < 5; ++s) { const float sv = sc[s * 2048 + k]; acc[s][0] += sv * w.x; acc[s][1] += sv * w.y; } }
#pragma unroll
            for (int s = 0; s < 5; ++s) { part[(wave * 5 + s) * 128 + lane * 2] = acc[s][0]; part[(wave * 5 + s) * 128 + lane * 2 + 1] = acc[s][1]; }
            __syncthreads();
            for (int i = tid; i < 640; i += 512) { const int s = i >> 7, cc = i & 127; float v = INP(5)[l * 6144 + col0 + cc];
#pragma unroll
                for (int w = 0; w < 8; ++w) v += part[(w * 5 + s) * 128 + cc];
                const int col = col0 + cc;
                if (col >= 4096) v *= INP(7)[l * 2048 + col - 4096]; else if (col >= 2048) v = (1.f + v) * INP(6)[l * 2048 + col - 2048];
                mod[(size_t)(l * 5 + s) * 6144 + col] = v; }
            __syncthreads();
        }
    }
    {
        bf16_t* wsb = (bf16_t*)(ws + WS_WSB); const float* w_s = INP(16);
        for (int i = (bid * 512 + tid) * 4; i < 4 * 16 * 16384; i += G * 512 * 4) { const f32x4 v = *(const f32x4*)(w_s + i);
            u32x2 o; o.x = cvt_pk_bf16(v.x, v.y); o.y = cvt_pk_bf16(v.z, v.w); *(u32x2*)(wsb + i) = o; }
    }
    convert_layer_weights(a, ws, 0, bid * 8 + wave, G * 8, lds, wave, lane);
}

__device__ __forceinline__ void phase_A(const Args& a, unsigned char* ws, const int bid, int l, int wave, int lane) {
    const int gw = bid * 8 + wave, NGW = gridDim.x * 8;
    const float* mod = (const float*)(ws + WS_MOD);
    float* ctxall = (float*)(ws + WS_CTX);
    bf16_t* hx = (bf16_t*)(ws + WS_HX);
    const bf16_t* z = (const bf16_t*)(ws + WS_Z);
#pragma unroll 1
    for (int seg = (l == 4 ? 1 : 0); seg < 5; ++seg) {
        const int s = seg == 0 ? 4 : seg - 1, rbeg = seg == 0 ? 0 : TCTX + (seg - 1) * SEQ, rend = seg == 0 ? TCTX : rbeg + SEQ;
        f32x4 G2[8], S2[8], SH[8];
        if (l >= 1) { const float* gp = mod + (size_t)((l - 1) * 5 + s) * 6144 + 4096 + lane * 4;
#pragma unroll
            for (int j = 0; j < 8; ++j) G2[j] = *(const f32x4*)(gp + j * 256); }
        if (l < 4) { const float* sp = mod + (size_t)(l * 5 + s) * 6144 + lane * 4;
#pragma unroll
            for (int j = 0; j < 8; ++j) { SH[j] = *(const f32x4*)(sp + j * 256); S2[j] = *(const f32x4*)(sp + 2048 + j * 256); } }
#pragma unroll 1
        for (int r = rbeg + gw; r < rend; r += NGW) {
            if (l < 4 && lane == 0) { ((float*)(ws + WS_RVS))[r] = 0.f; ((float*)(ws + WS_YBS))[r] = 0.f; }
            const float* src; float* dst;
            if (r < TCTX) { dst = ctxall + (size_t)r * D; src = (l <= 1) ? INP(2) + (size_t)r * D : dst; }
            else { dst = a.out + (size_t)(r - TCTX) * D; src = (l <= 1) ? INP(0) + (size_t)(r - TCTX) * D : dst; }
            f32x4 xv[8];
#pragma unroll
            for (int j = 0; j < 8; ++j) xv[j] = __builtin_nontemporal_load((const f32x4*)(src + j * 256 + lane * 4));
            if (l >= 1) {
                const bf16_t* orow = z + (size_t)r * ZW;
                f32x4 ov[8]; float ss = 0.f;
                if (r < TCTX) {
                    const float* pp = (const float*)(ws + WS_XBC) + (size_t)r * 2048 + lane * 4;
#pragma unroll
                    for (int j = 0; j < 8; ++j) { f32x4 acc4 = *(const f32x4*)(pp + j * 256);
#pragma unroll
                        for (int kc = 1; kc < 8; ++kc) acc4 = acc4 + *(const f32x4*)(pp + (size_t)kc * TCTX * 2048 + j * 256);
                        ov[j] = acc4; }
                } else {
#pragma unroll
                    for (int j = 0; j < 8; ++j) { const u32x2 ob = __builtin_nontemporal_load((const u32x2*)(orow + j * 256 + lane * 4)); ov[j] = (f32x4){bflo(ob.x), bfhi(ob.x), bflo(ob.y), bfhi(ob.y)}; }
                }
#pragma unroll
                for (int j = 0; j < 8; ++j) ss += (ov[j].x * ov[j].x + ov[j].y * ov[j].y) + (ov[j].z * ov[j].z + ov[j].w * ov[j].w);
                const float ro = rsqrtf(wave_sum(ss) * (1.f / D) + EPS);
#pragma unroll
                for (int j = 0; j < 8; ++j) { xv[j] = xv[j] + G2[j] * (ov[j] * ro); *(f32x4*)(dst + j * 256 + lane * 4) = xv[j]; }
            }
            if (l < 4) {
                float ss = 0.f;
#pragma unroll
                for (int j = 0; j < 8; ++j) ss += (xv[j].x * xv[j].x + xv[j].y * xv[j].y) + (xv[j].z * xv[j].z + xv[j].w * xv[j].w);
                const float rx = rsqrtf(wave_sum(ss) * (1.f / D) + EPS);
#pragma unroll
                for (int j = 0; j < 8; ++j) { const int col = j * 256 + lane * 4;
                    const f32x4 hv = (xv[j] * rx) * S2[j] + SH[j];
                    u32x2 o; o.x = cvt_pk_bf16(hv.x, hv.y); o.y = cvt_pk_bf16(hv.z, hv.w);
                    *(u32x2*)(hx + (size_t)r * D + col) = o; }
            }
        }
    }
}

__device__ __forceinline__ void mlp_phase(const Args& a, unsigned char* ws, const int bid, int l, LAS unsigned char* lds, int tid, int wave, int lane) {
    bf16_t* z = (bf16_t*)(ws + WS_Z);
    const bf16_t* wsb = (const bf16_t*)(ws + WS_WSB) + (size_t)l * 16 * 16384;
    const float* rvs = (const float*)(ws + WS_RVS); float* ybs = (float*)(ws + WS_YBS);
    const float* g_v = INP(15) + l * 2048; const float* b_s = INP(17) + l * 16 * 128;
    LAS unsigned char* L_W = lds; LAS unsigned char* L_V = lds + 34816;
    const int fr = lane & 15, fq = lane >> 4, wr = wave >> 1, wc = wave & 1;
    const int G = gridDim.x;
    u32x4 tw[4], tv[4]; float trk[4]; f32x4 tg0, tg1;
    const bool wfixed = (G & 15) == 0;
#define MLP_ISSUE(it) do { const int _gc = (it) >> 4, _g = (it) & 15; \
        _Pragma("unroll") for (int i = 0; i < 4; ++i) { const int p = tid + i * 512, r = p >> 4, cp = p & 15; \
            if (!wfixed) tw[i] = *(const u32x4*)(wsb + (size_t)_g * 16384 + r * 128 + cp * 8); \
            tv[i] = __builtin_nontemporal_load((const u32x4*)(z + (size_t)(_gc * 128 + r) * ZW + ZC_V + _g * 128 + cp * 8)); \
            trk[i] = rvs[_gc * 128 + r]; } \
        tg0 = *(const f32x4*)(g_v + _g * 128 + (tid & 15) * 8); tg1 = *(const f32x4*)(g_v + _g * 128 + (tid & 15) * 8 + 4); } while (0)
    if (wfixed && bid < NCH * 16) {
#pragma unroll
        for (int i = 0; i < 4; ++i) { const int p = tid + i * 512, r = p >> 4, cp = p & 15; *(LAS u32x4*)(L_W + r * 272 + cp * 16) = *(const u32x4*)(wsb + (size_t)(bid & 15) * 16384 + r * 128 + cp * 8); } }
    if (bid < NCH * 16) MLP_ISSUE(bid);
#pragma unroll 1
    for (int it = bid; it < NCH * 16; it += G) {
        const int gc = it >> 4, g = it & 15, row0 = gc * 128;
#pragma unroll
        for (int i = 0; i < 4; ++i) { const int p = tid + i * 512, r = p >> 4, cp = p & 15;
            if (!wfixed) *(LAS u32x4*)(L_W + r * 272 + cp * 16) = tw[i];
            float f[8]; unpack8(tv[i], f); const float rk = rsqrtf(trk[i] * (1.f / 2048.f) + EPS);
            const f32x4 g0 = tg0, g1 = tg1;
            float o[8] = {f[0] * rk * g0.x, f[1] * rk * g0.y, f[2] * rk * g0.z, f[3] * rk * g0.w, f[4] * rk * g1.x, f[5] * rk * g1.y, f[6] * rk * g1.z, f[7] * rk * g1.w};
            *(LAS u32x4*)(L_V + offb(r, cp)) = pack8(o); }
        u32x4 pu[2][2]; float pbias[2];
#pragma unroll
        for (int i = 0; i < 2; ++i) { const int q = (2 * wr + i) * 16 + fr; const bf16_t* zr = z + (size_t)(row0 + q) * ZW; pbias[i] = b_s[g * 128 + q];
#pragma unroll
            for (int m = 0; m < 2; ++m) { const int d0 = g * 128 + 32 * (2 * wc + m) + 8 * fq; pu[i][m] = __builtin_nontemporal_load((const u32x4*)(zr + ZC_U + d0)); } }
        LDS_BARRIER();
        if (it + G < NCH * 16) MLP_ISSUE(it + G);
        f32x4 acc[2][4];
#pragma unroll
        for (int i = 0; i < 2; ++i)
#pragma unroll
            for (int j = 0; j < 4; ++j) acc[i][j] = (f32x4){0.f, 0.f, 0.f, 0.f};
#pragma unroll
        for (int s = 0; s < 4; ++s) { bf16x8 wf[2], vf[4];
#pragma unroll
            for (int i = 0; i < 2; ++i) wf[i] = *(const LAS bf16x8*)(L_W + ((2 * wr + i) * 16 + fr) * 272 + s * 64 + fq * 16);
#pragma unroll
            for (int j = 0; j < 4; ++j) vf[j] = ldfrag_tr_bp(L_V, 32 * s, 4 * wc + j, lane);
            __builtin_amdgcn_sched_barrier(0);
#pragma unroll
            for (int i = 0; i < 2; ++i)
#pragma unroll
                for (int j = 0; j < 4; ++j) acc[i][j] = MFMA16(vf[j], wf[i], acc[i][j]);
            __builtin_amdgcn_sched_barrier(0); }
#pragma unroll
        for (int i = 0; i < 2; ++i) { const int q = (2 * wr + i) * 16 + fr; const float bias = pbias[i];
            bf16_t* zr = z + (size_t)(row0 + q) * ZW; float ss = 0.f;
#pragma unroll
            for (int m = 0; m < 2; ++m) { const int d0 = g * 128 + 32 * (2 * wc + m) + 8 * fq;
                float uf[8]; unpack8(pu[i][m], uf);
                float o[8];
#pragma unroll
                for (int r = 0; r < 4; ++r) { o[r] = uf[r] * (acc[i][2 * m][r] + bias); o[4 + r] = uf[4 + r] * (acc[i][2 * m + 1][r] + bias); }
#pragma unroll
                for (int e = 0; e < 8; ++e) ss += o[e] * o[e];
                *(u32x4*)(zr + ZC_U + d0) = pack8(o); }
            ss += __shfl_xor(ss, 16); ss += __shfl_xor(ss, 32);
            if (fq == 0) unsafeAtomicAdd(ybs + row0 + q, ss); }
        LDS_BARRIER();
    }
#undef MLP_ISSUE
}

__device__ __forceinline__ void conv_stream(const Args& a, unsigned char* ws, const int bid, int l, int tid) {
    const bf16_t* z = (const bf16_t*)(ws + WS_Z); bf16_t* xbc = (bf16_t*)(ws + WS_XBC);
    const int c0 = tid * 8;
    const float* cw = INP(9) + (size_t)l * 5 * 4096 + c0; const float* cbias = INP(10) + l * 4096 + c0;
    float w[5][8], bias[8];
#pragma unroll
    for (int k = 0; k < 5; ++k) { const f32x4 w0 = *(const f32x4*)(cw + k * 4096), w1 = *(const f32x4*)(cw + k * 4096 + 4);
        w[k][0] = w0.x; w[k][1] = w0.y; w[k][2] = w0.z; w[k][3] = w0.w; w[k][4] = w1.x; w[k][5] = w1.y; w[k][6] = w1.z; w[k][7] = w1.w; }
    { const f32x4 b0 = *(const f32x4*)cbias, b1 = *(const f32x4*)(cbias + 4); bias[0] = b0.x; bias[1] = b0.y; bias[2] = b0.z; bias[3] = b0.w; bias[4] = b1.x; bias[5] = b1.y; bias[6] = b1.z; bias[7] = b1.w; }
    for (int tg = bid; tg < T / 8; tg += gridDim.x) {
        const int tb = tg * 8;
        bool lo_ok, hi_ok;
        if (tb < TCTX) { lo_ok = (tb & 255) != 0; hi_ok = ((tb + 8) & 255) != 0; }
        else { lo_ok = ((tb - TCTX) & 63) != 0; hi_ok = ((tb + 8 - TCTX) & 63) != 0; }
        u32x4 rows[12];
#pragma unroll
        for (int j = 0; j < 12; ++j) { const bool ok = (j >= 2 && j < 10) || (j < 2 && lo_ok) || (j >= 10 && hi_ok);
            rows[j] = ok ? __builtin_nontemporal_load((const u32x4*)(z + (size_t)(tb - 2 + j) * ZW + c0)) : (u32x4){0u, 0u, 0u, 0u}; }
#pragma unroll
        for (int e = 0; e < 8; ++e) { float acc[8];
#pragma unroll
            for (int c = 0; c < 8; ++c) acc[c] = bias[c];
#pragma unroll
            for (int k = 0; k < 5; ++k) { float f[8]; unpack8(rows[e + k], f);
#pragma unroll
                for (int c = 0; c < 8; ++c) acc[c] += w[k][c] * f[c]; }
#pragma unroll
            for (int c = 0; c < 8; ++c) acc[c] = silu_f(acc[c]);
            *(u32x4*)(xbc + (size_t)(tb + e) * 4096 + c0) = pack8(acc); }
    }
}

__device__ __forceinline__ void phase_C0(const Args& a, unsigned char* ws, const int bid, int l, LAS unsigned char* lds, int tid, int wave, int lane) {
    const int G = gridDim.x;
    { const bf16_t* z = (const bf16_t*)(ws + WS_Z); float* DT = (float*)(ws + WS_DT); const float* dtb = INP(11) + l * 64;
      for (int idx = bid * 512 + tid; idx < T * 64; idx += G * 512) { const int t = idx >> 6, j = idx & 63;
          const float xr = bf1(z[(size_t)t * ZW + ZC_DT + j]) + dtb[j];
          const float e = __expf(-fabsf(xr)), u = 1.f + e;
          const float l1p = (u == 1.f) ? e : __logf(u) * e * __builtin_amdgcn_rcpf(u - 1.f);
          DT[idx] = fmaxf(xr, 0.f) + l1p; } }
    mlp_phase(a, ws, bid, l, lds, tid, wave, lane);
    conv_stream(a, ws, bid, l, tid);
#ifdef CONV_REP
    conv_stream(a, ws, bid, l, tid);
#endif
}

__device__ __forceinline__ void phase_C1(const Args& a, unsigned char* ws, const int bid, int l, LAS unsigned char* lds, int tid, int wave, int lane) {
    bf16_t* z = (bf16_t*)(ws + WS_Z);
    const bf16_t* xbc = (const bf16_t*)(ws + WS_XBC);
    const float* DT = (const float*)(ws + WS_DT);
    LAS unsigned char* L_C = lds; LAS unsigned char* L_B = lds + 34816; LAS unsigned char* L_M = lds + 69632; LAS unsigned char* L_X = lds + 104448; LAS unsigned char* L_H = lds + 122880;
    LAS float* cs = (LAS float*)(lds + 140288); LAS float* dtv = cs + 128; LAS float* wgt = cs + 256; LAS float* ecs = cs + 384; LAS float* f2dt = cs + 512; LAS float* refarr = cs + 640; LAS float* totp = cs + 656;
    const int fr = lane & 15, fq = lane >> 4, wr = wave >> 1, wc = wave & 1;
    const int qt = wave < 4 ? wave : 11 - wave;
    const int rb = fr * 272 + fq * 16;
    const int trB = (8 * fq + (fr >> 2)) * 272 + 8 * (lane & 3);
    const int trX = (8 * fq + (fr >> 2)) * 144 + 8 * (lane & 3);
    const int trXp = (8 * fq + (fr >> 2)) * 144 + 16 * (lane & 3);
    const int rbH = (8 * (fr >> 2) + (fr & 3)) * 272 + fq * 16;
    const unsigned offCB = (unsigned)(tid >> 4) * 4096u + (unsigned)(tid & 15) * 8u, offX = (unsigned)(tid >> 3) * 4096u + (unsigned)(tid & 7) * 8u;
    const int wCB = (tid >> 4) * 272 + (tid & 15) * 16, wX = (tid >> 3) * 144 + (tid & 7) * 16;
#define TRB(base, krow0, col0, t) __builtin_amdgcn_ds_read_tr16_b64_v4i16((LAS s16x4*)((base) + trB + ((krow0) + 4 * (t)) * 272 + (col0) * 2))
#define TRX(base, krow0, col0, t) __builtin_amdgcn_ds_read_tr16_b64_v4i16((LAS s16x4*)((base) + trX + ((krow0) + 4 * (t)) * 144 + (col0) * 2))
    for (int item = bid; item < 256; item += gridDim.x) {
        const int combo = (item & 7) * 8 + (item >> 5), hq = (item >> 3) & 3;
        const int b = combo >> 4, g = (combo >> 1) & 7, dir = combo & 1, h = 4 * g + hq;
        const float Acoef = -__expf(INP(12)[l * 64 + dir * 32 + h]);
        const float dskip = INP(13)[l * 32 + h];
        f32x4 Hacc[4];
#pragma unroll
        for (int j = 0; j < 4; ++j) Hacc[j] = (f32x4){0.f, 0.f, 0.f, 0.f};
        for (int i = tid; i < 17408 / 4; i += 512) ((LAS unsigned*)L_H)[i] = 0u;
        u32x4 pc[4], pb[4], px[2]; float pd0 = 0.f, pd1 = 0.f;
#define SSD_GC(step) ((dir == 0) ? ((step) < 2 ? 2 * b + (step) : 8 + b * 64 + ((step) - 2)) : ((step) < 2 ? 2 * b + (1 - (step)) : 8 + b * 64 + (65 - (step))))
#define SSD_ISSUE(step) do { const int _r0 = SSD_GC(step) * 128; const bf16_t* _cb = xbc + (size_t)_r0 * 4096 + 2048 + g * 128; const bf16_t* _xb = xbc + (size_t)_r0 * 4096 + h * 64; \
            _Pragma("unroll") for (int i = 0; i < 4; ++i) { pc[i] = *(const u32x4*)(_cb + 1024 + (size_t)i * 32 * 4096 + offCB); pb[i] = *(const u32x4*)(_cb + (size_t)i * 32 * 4096 + offCB); } \
            _Pragma("unroll") for (int i = 0; i < 2; ++i) px[i] = *(const u32x4*)(_xb + (size_t)i * 64 * 4096 + offX); \
            if (wave == 0) { pd0 = DT[(size_t)(_r0 + 2 * lane) * 64 + dir * 32 + h]; pd1 = DT[(size_t)(_r0 + 2 * lane + 1) * 64 + dir * 32 + h]; } } while (0)
        SSD_ISSUE(0);
#pragma unroll 1
        for (int step = 0; step < 66; ++step) {
            const int row0 = SSD_GC(step) * 128;
#pragma unroll
            for (int i = 0; i < 4; ++i) { *(LAS u32x4*)(L_C + wCB + i * 32 * 272) = pc[i]; *(LAS u32x4*)(L_B + wCB + i * 32 * 272) = pb[i]; }
#pragma unroll
            for (int i = 0; i < 2; ++i) *(LAS u32x4*)(L_X + wX + i * 64 * 144) = px[i];
            if (wave == 0) {
                const int t0 = 2 * lane;
                const float d0 = pd0, d1 = pd1;
                const float a0 = d0 * Acoef, a1 = d1 * Acoef, pair = a0 + a1; const float incl = wave_incl_scan(pair);
                const float tot = __builtin_bit_cast(float, __builtin_amdgcn_readlane(__builtin_bit_cast(int, incl), 63)), excl = incl - pair;
                float c0v, c1v, ref;
                if (dir == 0) { c0v = excl + a0; c1v = incl; ref = __shfl(c1v, (lane & ~7) + 7); }
                else { c0v = tot - excl; c1v = tot - incl + a1; ref = __shfl(c0v, lane & ~7); }
                cs[t0] = c0v; cs[t0 + 1] = c1v; dtv[t0] = d0; dtv[t0 + 1] = d1;
                wgt[t0] = d0 * __expf(tot - c0v); wgt[t0 + 1] = d1 * __expf(tot - c1v);
                ecs[t0] = __expf(c0v); ecs[t0 + 1] = __expf(c1v);
                f2dt[t0] = d0 * __expf(ref - c0v); f2dt[t0 + 1] = d1 * __expf(ref - c1v);
                if ((lane & 7) == 0) refarr[lane >> 3] = ref;
                if (lane == 0) totp[0] = tot;
            }
            LDS_BARRIER();
            if (step + 1 < 66) SSD_ISSUE(step + 1);
            f32x4 accA[8], accC[4];
#pragma unroll
            for (int j = 0; j < 8; ++j) accA[j] = (f32x4){0.f, 0.f, 0.f, 0.f};
#pragma unroll
            for (int j = 0; j < 4; ++j) accC[j] = (f32x4){0.f, 0.f, 0.f, 0.f};
            {
                bf16x8 cqv[2], bq[2][4], hq[2][2];
#define SSD_LDH(buf, h_) do { const int _s = (h_) >> 1, _hf = (h_) & 1; if (_hf == 0) cqv[_s & 1] = *(const LAS bf16x8*)(L_C + qt * (16 * 272) + rb + _s * 64); \
                    _Pragma("unroll") for (int k = 0; k < 4; ++k) bq[buf][k] = *(const LAS bf16x8*)(L_B + (4 * _hf + k) * (16 * 272) + rb + _s * 64); \
                    _Pragma("unroll") for (int p = 0; p < 2; ++p) hq[buf][p] = *(const LAS bf16x8*)(L_H + (32 * _hf + 4 * p) * 272 + rbH + _s * 64); } while (0)
                SSD_LDH(0, 0);
#pragma unroll
                for (int h2 = 0; h2 < 8; ++h2) { const int cb = h2 & 1, s_ = h2 >> 1, hf_ = h2 & 1;
                    if (h2 < 7) SSD_LDH(cb ^ 1, h2 + 1);
                    __builtin_amdgcn_sched_barrier(0);
#pragma unroll
                    for (int k = 0; k < 4; ++k) accA[4 * hf_ + k] = MFMA16(bq[cb][k], cqv[s_ & 1], accA[4 * hf_ + k]);
#pragma unroll
                    for (int p = 0; p < 2; ++p) accC[2 * hf_ + p] = MFMA16(hq[cb][p], cqv[s_ & 1], accC[2 * hf_ + p]);
                    __builtin_amdgcn_sched_barrier(0); }
#undef SSD_LDH
            }
            { const float etot = __expf(totp[0]);
#pragma unroll
              for (int j = 0; j < 4; ++j) Hacc[j] = Hacc[j] * etot;
#pragma unroll
              for (int s = 0; s < 4; ++s) { const s16x4 xlo = TRX(L_X, 32 * s, 16 * wr, 0), xhi = TRX(L_X, 32 * s, 16 * wr, 1);
                  const f32x4 w0 = *(const LAS f32x4*)(wgt + s * 32 + fq * 8), w1 = *(const LAS f32x4*)(wgt + s * 32 + fq * 8 + 4);
                  s16x4 blo[4], bhi[4];
#pragma unroll
                  for (int j = 0; j < 4; ++j) { blo[j] = TRB(L_B, 32 * s, 16 * (4 * wc + j), 0); bhi[j] = TRB(L_B, 32 * s, 16 * (4 * wc + j), 1); }
                  __builtin_amdgcn_sched_barrier(0);
                  const u32x2 xl = __builtin_bit_cast(u32x2, xlo), xh = __builtin_bit_cast(u32x2, xhi);
                  u32x4 xs; xs.x = cvt_pk_bf16(bflo(xl.x) * w0.x, bfhi(xl.x) * w0.y); xs.y = cvt_pk_bf16(bflo(xl.y) * w0.z, bfhi(xl.y) * w0.w);
                  xs.z = cvt_pk_bf16(bflo(xh.x) * w1.x, bfhi(xh.x) * w1.y); xs.w = cvt_pk_bf16(bflo(xh.y) * w1.z, bfhi(xh.y) * w1.w);
                  const bf16x8 xq = __builtin_bit_cast(bf16x8, xs);
#pragma unroll
                  for (int j = 0; j < 4; ++j) { const bf16x8 bt = (bf16x8){blo[j].x, blo[j].y, blo[j].z, blo[j].w, bhi[j].x, bhi[j].y, bhi[j].z, bhi[j].w};
                      Hacc[j] = MFMA16(bt, xq, Hacc[j]); }
                  __builtin_amdgcn_sched_barrier(0); } }
            { const int q = qt * 16 + fr; const float csq = cs[q], eq = ecs[q];
              f32x4 gd = accA[0];
#pragma unroll
              for (int kt = 1; kt < 8; ++kt) { const bool is = (kt == qt); gd.x = is ? accA[kt].x : gd.x; gd.y = is ? accA[kt].y : gd.y; gd.z = is ? accA[kt].z : gd.z; gd.w = is ? accA[kt].w : gd.w; }
#pragma unroll
              for (int kt = 0; kt < 8; ++kt) { const int k0 = kt * 16 + fq * 4;
                  const bool kept = dir == 0 ? (kt < qt) : (kt > qt);
                  const float f1 = __expf(csq - refarr[kt]); const f32x4 f2 = *(const LAS f32x4*)(f2dt + k0);
                  float m[4];
#pragma unroll
                  for (int r = 0; r < 4; ++r) m[r] = kept ? accA[kt][r] * f1 * f2[r] : 0.f;
                  u32x2 o; o.x = cvt_pk_bf16(m[0], m[1]); o.y = cvt_pk_bf16(m[2], m[3]);
                  *(LAS u32x2*)(L_M + q * 272 + k0 * 2) = o; }
              { const int k0 = qt * 16 + fq * 4; const f32x4 ck = *(const LAS f32x4*)(cs + k0), dk = *(const LAS f32x4*)(dtv + k0); float m[4];
#pragma unroll
                for (int r = 0; r < 4; ++r) { const int kk = k0 + r; const bool keep = dir == 0 ? (kk <= q) : (kk >= q); m[r] = keep ? gd[r] * __expf(csq - ck[r]) * dk[r] : 0.f; }
                u32x2 o; o.x = cvt_pk_bf16(m[0], m[1]); o.y = cvt_pk_bf16(m[2], m[3]);
                *(LAS u32x2*)(L_M + q * 272 + k0 * 2) = o; }
              f32x4 accB[4];
#pragma unroll
              for (int j = 0; j < 4; ++j) accB[j] = (f32x4){0.f, 0.f, 0.f, 0.f};
#pragma unroll
              for (int s = 0; s < 4; ++s) { const bf16x8 mq = *(const LAS bf16x8*)(L_M + qt * (16 * 272) + rb + s * 64);
                  s16x4 xlo[4], xhi[4];
#pragma unroll
                  for (int pt = 0; pt < 4; ++pt) { xlo[pt] = __builtin_amdgcn_ds_read_tr16_b64_v4i16((LAS s16x4*)(L_X + trXp + (32 * s) * 144 + (32 * (pt >> 1) + 4 * (pt & 1)) * 2));
                      xhi[pt] = __builtin_amdgcn_ds_read_tr16_b64_v4i16((LAS s16x4*)(L_X + trXp + (32 * s + 4) * 144 + (32 * (pt >> 1) + 4 * (pt & 1)) * 2)); }
                  __builtin_amdgcn_sched_barrier(0);
#pragma unroll
                  for (int pt = 0; pt < 4; ++pt) { const bf16x8 xf = (bf16x8){xlo[pt].x, xlo[pt].y, xlo[pt].z, xlo[pt].w, xhi[pt].x, xhi[pt].y, xhi[pt].z, xhi[pt].w}; accB[pt] = MFMA16(xf, mq, accB[pt]); }
                  __builtin_amdgcn_sched_barrier(0); }
              bf16_t* yrow = z + (size_t)(row0 + q) * ZW + dir * 2048 + h * 64 + 8 * fq;
#pragma unroll
              for (int m = 0; m < 2; ++m) { float y[8];
#pragma unroll
                  for (int r = 0; r < 4; ++r) { y[r] = accB[2 * m][r] + eq * accC[2 * m][r]; y[4 + r] = accB[2 * m + 1][r] + eq * accC[2 * m + 1][r]; }
                  if (dir == 0) { const u32x4 xv = *(const LAS u32x4*)(L_X + q * 144 + (32 * m + 8 * fq) * 2); float xf8[8]; unpack8(xv, xf8);
#pragma unroll
                      for (int e = 0; e < 8; ++e) y[e] += dskip * xf8[e]; }
                  *(u32x4*)(yrow + 32 * m) = pack8(y); } }
            LDS_BARRIER();
#pragma unroll
            for (int j = 0; j < 4; ++j) { u32x2 o; o.x = cvt_pk_bf16(Hacc[j][0], Hacc[j][1]); o.y = cvt_pk_bf16(Hacc[j][2], Hacc[j][3]);
                *(LAS u32x2*)(L_H + (wr * 16 + fr) * 272 + ((4 * wc + j) * 16 + fq * 4) * 2) = o; }
        }
        __syncthreads();
#undef SSD_GC
#undef SSD_ISSUE
    }
#undef TRB
#undef TRX
}

__device__ __forceinline__ void phase_C2(const Args& a, unsigned char* ws, const int bid, int l, int wave, int lane) {
    bf16_t* z = (bf16_t*)(ws + WS_Z);
    const float* g_ssd = INP(14) + l * 2048; const float* g_mlp = INP(18) + l * 2048;
    const int gw = bid * 8 + wave, NGW = gridDim.x * 8;
    f32x4 gs[8];
#pragma unroll
    for (int j = 0; j < 4; ++j) { gs[2 * j] = *(const f32x4*)(g_ssd + j * 512 + lane * 8); gs[2 * j + 1] = *(const f32x4*)(g_ssd + j * 512 + lane * 8 + 4); }
    for (int r = gw + (l == 3 ? TCTX : 0); r < T; r += NGW) {
        bf16_t* zr = z + (size_t)r * ZW;
        const float ybr = ((const float*)(ws + WS_YBS))[r];
        float yv[32]; float ss = 0.f;
#pragma unroll
        for (int j = 0; j < 4; ++j) { const int col = j * 512 + lane * 8;
            const u32x4 yf = __builtin_nontemporal_load((const u32x4*)(zr + col)), yb = __builtin_nontemporal_load((const u32x4*)(zr + 2048 + col)), zs = __builtin_nontemporal_load((const u32x4*)(zr + ZC_ZSSD + col));
            float f0[8], f1[8], f2[8]; unpack8(yf, f0); unpack8(yb, f1); unpack8(zs, f2);
#pragma unroll
            for (int e = 0; e < 8; ++e) { const float y = (f0[e] + f1[e]) * silu_f(f2[e]); yv[j * 8 + e] = y; ss += y * y; } }
        const float ra = rsqrtf(wave_sum(ss) * (1.f / 2048.f) + EPS) * sqrtf(ybr * (1.f / 2048.f) + EPS);
#pragma unroll
        for (int j = 0; j < 4; ++j) { const int col = j * 512 + lane * 8;
            const f32x4 g0 = gs[2 * j], g1 = gs[2 * j + 1];
            float o[8] = {yv[j * 8 + 0] * ra * g0.x, yv[j * 8 + 1] * ra * g0.y, yv[j * 8 + 2] * ra * g0.z, yv[j * 8 + 3] * ra * g0.w,
                          yv[j * 8 + 4] * ra * g1.x, yv[j * 8 + 5] * ra * g1.y, yv[j * 8 + 6] * ra * g1.z, yv[j * 8 + 7] * ra * g1.w};
            *(u32x4*)(zr + ZC_ZSSD + col) = pack8(o); }
    }
}

__global__ void __launch_bounds__(512, 2) mk_fwd(Args a) {
    extern __shared__ __attribute__((aligned(16))) unsigned char lds_raw[];
    LAS unsigned char* lds = (LAS unsigned char*)lds_raw;
    cg::grid_group grid = cg::this_grid();
    { LAS unsigned* stw = (LAS unsigned*)(lds + LDS_BAR_OFF); if (threadIdx.x < 4) stw[threadIdx.x] = 0u; }
    __syncthreads();
    (void)xcd_barrier_post((unsigned*)(a.ws + WS_BAR), (volatile LAS unsigned*)(lds + LDS_BAR_OFF));
    int ph = a.ph_lo, rep = 0, nsync = 0; bool first = true;
#ifdef SYNC_PROBE
    for (int i = 0; i < 100; ++i) { XcdBarrier xb; xb.bar = (unsigned*)(a.ws + WS_BAR); xb.x = xb_xcc_id(); xb.st = (volatile LAS unsigned*)(lds + LDS_BAR_OFF); xcd_barrier(xb); }
#endif
#pragma unroll 1
    while (ph < a.ph_hi) {
        if (!first) { if (nsync == 0) grid.sync(); else { XcdBarrier xb; xb.bar = (unsigned*)(a.ws + WS_BAR); xb.x = xb_xcc_id(); xb.st = (volatile LAS unsigned*)(lds + LDS_BAR_OFF); xcd_barrier(xb); } ++nsync; }
        first = false;
        int tid = threadIdx.x; asm volatile("" : "+v"(tid));
        int bid = blockIdx.x; asm volatile("" : "+s"(bid));
        long zo = 0; asm volatile("" : "+s"(zo)); unsigned char* ws = a.ws + zo;
        const int wave = __builtin_amdgcn_readfirstlane(tid >> 6), lane = tid & 63;
        const int l = (ph - 1) / 6, sub = (ph - 1) % 6;
        if (ph == 0) phase_prologue(a, ws, bid, lds, tid, wave, lane);
        else if (sub == 0) phase_A(a, ws, bid, l, wave, lane);
        else if (sub == 1 || sub == 5) {
            pg8::Gemm g; void* cout; int ldc, mode;
            int tail = 0; g.A2 = nullptr; g.P2 = nullptr; const float* rbs = nullptr; const float* rbs_tail = nullptr;
            if (sub == 1) { g.A = (const bf16_t*)(ws + WS_HX); g.Bt = (const bf16_t*)(ws + WS_WIN) + (size_t)l * ZW * 2048; g.M = T; g.N = ZW; g.K = 2048; g.lda = 2048; cout = ws + WS_Z; ldc = ZW; mode = 0; }
            else { const int r0 = TCTX; rbs = (const float*)(ws + WS_YBS) + r0; rbs_tail = (const float*)(ws + WS_YBS);
                if (l < 3) { tail = 1; g.A2 = (const bf16_t*)(ws + WS_Z) + 4096; g.P2 = (float*)(ws + WS_XBC); }
                g.A = (const bf16_t*)(ws + WS_Z) + (size_t)r0 * ZW + 4096; g.Bt = (const bf16_t*)(ws + WS_WOUT) + (size_t)l * 2048 * 4096; g.M = T - r0; g.N = 2048; g.K = 4096; g.lda = ZW;
                cout = (bf16_t*)(ws + WS_Z) + (size_t)r0 * ZW; ldc = ZW; mode = 0; }
            pg8::StaticOrder S; S.init(g.M, g.N, (int)gridDim.x, bid, tail);
            pg8::gemm_phase(tid, lds, g, S, mode, cout, ldc, sub == 1 ? (float*)(ws + WS_RVS) : (float*)nullptr, rbs, rbs_tail);
            if (sub == 1 && l < 3) {
                const int nlong = (ZW / 256) * (T / 256) - ((ZW / 256) * (T / 256) / (int)gridDim.x) * (int)gridDim.x, G_ = (int)gridDim.x;
                if (nlong > 0 && nlong < G_) { if (bid >= nlong) convert_layer_weights(a, ws, l + 1, (bid - nlong) * 8 + wave, (G_ - nlong) * 8, lds, wave, lane); }
                else convert_layer_weights(a, ws, l + 1, bid * 8 + wave, G_ * 8, lds, wave, lane);
            }
        }
        else if (sub == 2) phase_C0(a, ws, bid, l, lds, tid, wave, lane);
        else if (sub == 3) phase_C1(a, ws, bid, l, lds, tid, wave, lane);
        else phase_C2(a, ws, bid, l, wave, lane);
        const int reps = ((ph > 0 && ((REP_MASK >> sub) & 1)) || (ph == 0 && (REP_MASK & 64)) || (ph > 0 && sub == 0 && l <= 1 && (REP_MASK & 128))) ? 2 : 1;
        if (++rep >= reps) { rep = 0; ++ph; }
    }
}

extern "C" void kernel_launch(void* const* d_in, const int* in_sizes, int n_in, void* d_out, int out_size, void* d_ws, size_t ws_size, hipStream_t stream) {
    static int grid = 0;
    if (grid == 0) {
        if (n_in != 20 || ws_size < WS_END) { fprintf(stderr, "kernel_launch: need 20 inputs and %zu bytes of workspace (got %d, %zu)\n", (size_t)WS_END, n_in, ws_size); grid = -1; return; }
        int dev = 0, cus = 0, per_cu = 0;
        hipGetDevice(&dev);
        hipDeviceGetAttribute(&cus, hipDeviceAttributeMultiprocessorCount, dev);
        hipFuncSetAttribute((const void*)mk_fwd, hipFuncAttributeMaxDynamicSharedMemorySize, LDS_BYTES);
        if (hipOccupancyMaxActiveBlocksPerMultiprocessor(&per_cu, (const void*)mk_fwd, 512, LDS_BYTES) != hipSuccess || per_cu < 1) per_cu = 1;
        (void)hipGetLastError();
        grid = cus * per_cu;
    }
    if (grid < 0) return;
    Args a{};
    for (int i = 0; i < 20; ++i) a.in[i] = (const float*)d_in[i];
    a.out = (float*)d_out; a.ws = (unsigned char*)d_ws; a.ph_lo = 0; a.ph_hi = 26;
    if (hipMemsetAsync((char*)d_ws + WS_BAR, 0, XCD_BAR_WORDS * sizeof(unsigned), stream) != hipSuccess) { fprintf(stderr, "kernel_launch: memset of the barrier words failed\n"); return; }
    void* args[] = {&a};
    hipError_t e = hipLaunchCooperativeKernel((const void*)mk_fwd, dim3(grid), dim3(512), args, LDS_BYTES, stream);
    if (e != hipSuccess) fprintf(stderr, "cooperative launch failed: %s (grid %d)\n", hipGetErrorString(e), grid);
}
```

```cpp
#include <hip/hip_runtime.h>
#include <hip/hip_cooperative_groups.h>
#include <cstdio>
#include <cstdint>
namespace cg = cooperative_groups;

#define LAS __attribute__((address_space(3)))
typedef unsigned short bf16_t;
typedef short bf16x8 __attribute__((ext_vector_type(8)));
typedef float f32x4 __attribute__((ext_vector_type(4)));
typedef float f32x2 __attribute__((ext_vector_type(2)));
typedef unsigned u32x4 __attribute__((ext_vector_type(4)));
typedef unsigned u32x2 __attribute__((ext_vector_type(2)));

constexpr int D = 2048, NB = 4, SEQ = 8192, DEPTH = 4, CTXL = 256;
constexpr int TCTX = NB * CTXL;
constexpr int T = TCTX + NB * SEQ;
constexpr int NCH = T / 128;
constexpr int ZW = 12544;
constexpr int ZC_ZSSD = 4096, ZC_U = 6144, ZC_V = 8192, ZC_ZMLP = 10240, ZC_DT = 12288;
constexpr int INW = 12352;
constexpr float EPS = 1e-6f;
constexpr int LDS_BAR_OFF = 161280;
constexpr int LDS_BYTES = 161296;
#ifndef REP_MASK
#define REP_MASK 0
#endif

constexpr size_t WS_BAR = 0;
constexpr size_t WS_MOD = 16384;
constexpr size_t WS_WSB = WS_MOD + 491520;
constexpr size_t WS_RVS = WS_WSB + 2097152;
constexpr size_t WS_YBS = WS_RVS + (size_t)T * 4;
constexpr size_t WS_DT = WS_YBS + (size_t)T * 4;
constexpr size_t WS_CTX = WS_DT + (size_t)T * 64 * 4;
constexpr size_t WS_WIN = WS_CTX + (size_t)TCTX * D * 4;
constexpr size_t WS_WOUT = WS_WIN + (size_t)4 * ZW * D * 2;
constexpr size_t WS_HX = WS_WOUT + (size_t)4 * 2048 * 4096 * 2;
constexpr size_t WS_Z = WS_HX + (size_t)T * D * 2;
constexpr size_t WS_XBC = WS_Z + (size_t)T * ZW * 2;
constexpr size_t WS_END = WS_XBC + (size_t)T * 4096 * 2;

struct Args { const float* in[20]; float* out; unsigned char* ws; int ph_lo, ph_hi; };

__device__ __forceinline__ unsigned cvt_pk_bf16(float lo, float hi) { unsigned r; asm volatile("v_cvt_pk_bf16_f32 %0, %1, %2" : "=v"(r) : "v"(lo), "v"(hi)); return r; }
__device__ __forceinline__ float bflo(unsigned u) { return __builtin_bit_cast(float, u << 16); }
__device__ __forceinline__ float bfhi(unsigned u) { return __builtin_bit_cast(float, u & 0xffff0000u); }
__device__ __forceinline__ float bf1(bf16_t h) { return __builtin_bit_cast(float, ((unsigned)h) << 16); }
template <int CTRL, int ROWMASK> __device__ __forceinline__ float dpp_get0(float v) { return __builtin_bit_cast(float, __builtin_amdgcn_update_dpp(0, __builtin_bit_cast(int, v), CTRL, ROWMASK, 0xf, true)); }
__device__ __forceinline__ float wave_incl_scan(float v) {
    v += dpp_get0<0x111, 0xf>(v); v += dpp_get0<0x112, 0xf>(v); v += dpp_get0<0x114, 0xf>(v); v += dpp_get0<0x118, 0xf>(v);
    v += dpp_get0<0x142, 0xa>(v);
    v += dpp_get0<0x143, 0xc>(v);
    return v;
}
__device__ __forceinline__ float wave_sum(float v) {
    return __builtin_bit_cast(float, __builtin_amdgcn_readlane(__builtin_bit_cast(int, wave_incl_scan(v)), 63));
}
__device__ __forceinline__ float silu_f(float x) { return x * __builtin_amdgcn_rcpf(1.f + __expf(-x)); }
__device__ __forceinline__ void unpack8(const u32x4 v, float* f) {
    f[0] = bflo(v.x); f[1] = bfhi(v.x); f[2] = bflo(v.y); f[3] = bfhi(v.y); f[4] = bflo(v.z); f[5] = bfhi(v.z); f[6] = bflo(v.w); f[7] = bfhi(v.w);
}
__device__ __forceinline__ u32x4 pack8(const float* f) {
    u32x4 w; w.x = cvt_pk_bf16(f[0], f[1]); w.y = cvt_pk_bf16(f[2], f[3]); w.z = cvt_pk_bf16(f[4], f[5]); w.w = cvt_pk_bf16(f[6], f[7]); return w;
}
__device__ __forceinline__ const float* inp_(const float* p) { long zo = 0; asm volatile("" : "+s"(zo)); return p + zo; }
#define INP(k) inp_(a.in[k])
typedef short s16x4 __attribute__((ext_vector_type(4)));
__device__ __forceinline__ bf16x8 ldfrag_tr(LAS const unsigned char* base, const int pitch, const int krow0, const int col0, const int lane) {
    const int g = lane >> 4, q = (lane & 15) >> 2, p = lane & 3;
    LAS const unsigned char* a0 = base + (krow0 + 8 * g + q) * pitch + (col0 + 4 * p) * 2;
    const s16x4 lo = __builtin_amdgcn_ds_read_tr16_b64_v4i16((LAS s16x4*)a0);
    const s16x4 hi = __builtin_amdgcn_ds_read_tr16_b64_v4i16((LAS s16x4*)(a0 + 4 * pitch));
    return (bf16x8){lo.x, lo.y, lo.z, lo.w, hi.x, hi.y, hi.z, hi.w};
}
__device__ __forceinline__ int offb(const int row, const int ch) { return 256 * row + 16 * (ch ^ (((row & 3) << 2) | ((row >> 2) & 3))); }
__device__ __forceinline__ int offx(const int row, const int ch) { return 128 * row + 16 * (ch ^ ((((row >> 1) & 1) << 1) | (((row >> 3) & 1) << 2))); }
__device__ __forceinline__ bf16x8 ldfrag_tr_b(LAS const unsigned char* base, const int krow0, const int c, const int lane) {
    const int g = lane >> 4, q = (lane & 15) >> 2, p = lane & 3, row = krow0 + 8 * g + q;
    const s16x4 lo = __builtin_amdgcn_ds_read_tr16_b64_v4i16((LAS s16x4*)(base + offb(row, 2 * c + (p >> 1)) + 8 * (p & 1)));
    const s16x4 hi = __builtin_amdgcn_ds_read_tr16_b64_v4i16((LAS s16x4*)(base + offb(row + 4, 2 * c + (p >> 1)) + 8 * (p & 1)));
    return (bf16x8){lo.x, lo.y, lo.z, lo.w, hi.x, hi.y, hi.z, hi.w};
}
__device__ __forceinline__ bf16x8 ldfrag_tr_bp(LAS const unsigned char* base, const int krow0, const int c, const int lane) {
    const int g = lane >> 4, q = (lane & 15) >> 2, p = lane & 3, row = krow0 + 8 * g + q, ch = 4 * (c >> 1) + p, b8 = 8 * (c & 1);
    const s16x4 lo = __builtin_amdgcn_ds_read_tr16_b64_v4i16((LAS s16x4*)(base + offb(row, ch) + b8));
    const s16x4 hi = __builtin_amdgcn_ds_read_tr16_b64_v4i16((LAS s16x4*)(base + offb(row + 4, ch) + b8));
    return (bf16x8){lo.x, lo.y, lo.z, lo.w, hi.x, hi.y, hi.z, hi.w};
}
__device__ __forceinline__ bf16x8 ldfrag_tr_x(LAS const unsigned char* base, const int krow0, const int c, const int lane) {
    const int g = lane >> 4, q = (lane & 15) >> 2, p = lane & 3, row = krow0 + 8 * g + q;
    LAS const unsigned char* a0 = base + offx(row, 2 * c + (p >> 1)) + 8 * (p & 1);
    const s16x4 lo = __builtin_amdgcn_ds_read_tr16_b64_v4i16((LAS s16x4*)a0);
    const s16x4 hi = __builtin_amdgcn_ds_read_tr16_b64_v4i16((LAS s16x4*)(a0 + 512));
    return (bf16x8){lo.x, lo.y, lo.z, lo.w, hi.x, hi.y, hi.z, hi.w};
}
#define LDS_BARRIER() do { asm volatile("s_waitcnt lgkmcnt(0)" ::: "memory"); __builtin_amdgcn_s_barrier(); asm volatile("" ::: "memory"); } while (0)
#define MFMA16(a, b, c) __builtin_amdgcn_mfma_f32_16x16x32_bf16((a), (b), (c), 0, 0, 0)

namespace pg8 {
constexpr int BM = 256, BK = 64, HALF = 128, HTB = HALF * BK * 2, STAGE_BYTES = 8 * HTB, NXCD = 8, WGM = 8;
__device__ __forceinline__ int lds_byte(int r, int c) { const int st = (r >> 4) * 2 + (c >> 5), rr = r & 15, cc = c & 31, ob = rr * 64 + cc * 2; return st * 1024 + (ob ^ (((ob >> 9) & 1) << 5)); }
__device__ __forceinline__ void stage_rc(int b, int& R, int& C) { const int st = b / 1024, sb = b % 1024, swz = sb ^ (((sb >> 9) & 1) << 5); R = (st >> 1) * 16 + swz / 64; C = (st & 1) * 32 + (swz % 64) / 2; }
__device__ __forceinline__ int perm32(int rho) { const int n = rho >> 4, i = rho & 15; return 8 * (i >> 2) + 4 * n + (i & 3); }
struct Unit { int pm, pn, kc; };
struct Gemm { const bf16_t* A; const bf16_t* Bt; int M, N, K, lda; const bf16_t* A2; float* P2; };
struct StaticOrder {
    int nM, nN, nwg, G, c, tail;
    __device__ void init(int M, int N, int G_, int c_, int tail_) { nM = M / BM; nN = N / BM; nwg = nM * nN; G = G_; c = c_; tail = tail_; }
    __device__ bool next(int i, Unit& u) const {
        const long L = (long)i * G + c;
        if (L >= nwg) { const long t = L - nwg; if (!tail || t >= 256) return false; u.pm = (int)(t >> 6); u.pn = (int)(t >> 3) & 7; u.kc = (int)t & 7; return true; }
        u.kc = -1;
        int wgid = (int)L; { const int q = nwg / NXCD, r = nwg % NXCD, xcd = wgid % NXCD, off = wgid / NXCD; wgid = (xcd < r ? xcd * (q + 1) : r * (q + 1) + (xcd - r) * q) + off; }
        const int nig = WGM * nN, gid = wgid / nig, fm = gid * WGM, gsz = (nM - fm) < WGM ? (nM - fm) : WGM;
        u.pm = fm + ((wgid % nig) % gsz); u.pn = (wgid % nig) / gsz; return true;
    }
};
struct EpiF32 {
    static constexpr bool PERM = false;
    float* C; int ldc;
    __device__ __forceinline__ void operator()(const f32x4 (&acc)[2][2][4][2], const Unit& u, int wr, int wc, int fr, int fq) const {
        const int row0 = u.pm * BM + wr * 64 + fr, col0 = u.pn * BM + wc * 32 + 4 * fq;
#pragma unroll
        for (int ai = 0; ai < 2; ++ai)
#pragma unroll
            for (int m = 0; m < 4; ++m) { float* rowp = C + (size_t)(row0 + ai * HALF + m * 16) * ldc + col0;
#pragma unroll
                for (int bj = 0; bj < 2; ++bj)
#pragma unroll
                    for (int n = 0; n < 2; ++n) *(f32x4*)(rowp + bj * HALF + n * 16) = acc[ai][bj][m][n]; }
    }
};
struct EpiF32Perm {
    float* C; int ldc;
    __device__ __forceinline__ void operator()(const f32x4 (&acc)[2][2][4][2], const Unit& u, int wr, int wc, int fr, int fq) const {
        const int row0 = u.pm * BM + wr * 64 + fr, col0 = u.pn * BM + wc * 32 + 8 * fq;
#pragma unroll
        for (int ai = 0; ai < 2; ++ai)
#pragma unroll
            for (int m = 0; m < 4; ++m) { float* rowp = C + (size_t)(row0 + ai * HALF + m * 16) * ldc + col0;
#pragma unroll
                for (int bj = 0; bj < 2; ++bj) { *(f32x4*)(rowp + bj * HALF) = acc[ai][bj][m][0]; *(f32x4*)(rowp + bj * HALF + 4) = acc[ai][bj][m][1]; } }
    }
};
struct EpiBf16 {
    static constexpr bool PERM = true;
    bf16_t* O; int ldc;
    __device__ __forceinline__ void operator()(const f32x4 (&acc)[2][2][4][2], const Unit& u, int wr, int wc, int fr, int fq) const {
        const int row0 = u.pm * BM + wr * 64 + fr, col0 = u.pn * BM + wc * 32 + 8 * fq;
#pragma unroll
        for (int ai = 0; ai < 2; ++ai)
#pragma unroll
            for (int m = 0; m < 4; ++m) { bf16_t* rowp = O + (size_t)(row0 + ai * HALF + m * 16) * ldc + col0;
#pragma unroll
                for (int bj = 0; bj < 2; ++bj) { const f32x4 v0 = acc[ai][bj][m][0], v1 = acc[ai][bj][m][1];
                    u32x4 w; w.x = cvt_pk_bf16(v0[0], v0[1]); w.y = cvt_pk_bf16(v0[2], v0[3]); w.z = cvt_pk_bf16(v1[0], v1[1]); w.w = cvt_pk_bf16(v1[2], v1[3]);
                    __builtin_nontemporal_store(w, (u32x4*)(rowp + bj * HALF)); } }
    }
};

__device__ __forceinline__ void gemm_phase(const int tid, LAS unsigned char* lds, const Gemm g, const StaticOrder& S, const int mode  , void* Cout, const int ldc, float* rvs, const float* rbs, const float* rbs_tail) {
    const int wid = __builtin_amdgcn_readfirstlane(tid >> 6), lane = tid & 63, wr = wid >> 2, wc = wid & 3, fr = lane & 15, fq = lane >> 4;
    const int K = g.K, nt = K / BK, lda = g.lda;
    unsigned voffA[2], voffB[2];
#pragma unroll
    for (int i = 0; i < 2; ++i) { int R, C; stage_rc(tid * 16 + i * 8192, R, C); const int Rb = (mode == 0) ? ((R & ~31) + perm32(R & 31)) : R;
        voffA[i] = (unsigned)(R * lda + C) * 2u; voffB[i] = (unsigned)(Rb * K + C) * 2u; }
    const size_t kstep = (size_t)(BK * 2);
    const size_t hstepA = (size_t)HALF * lda * 2, hstepB = (size_t)HALF * K * 2;
    const size_t tstepA = 2 * hstepA, tstepB = 2 * hstepB;
    const unsigned ldsw = (unsigned)wid * 1024u;
    const int aoff = lds_byte(wr * 64 + fr, fq * 8), boff = lds_byte(wc * 32 + fr, fq * 8);
#define PG8_SA(b, h) (((b) * 2 + (h)) * HTB)
#define PG8_SB(b, h) ((4 + (b) * 2 + (h)) * HTB)
#define PG8_STAGE(bufoff, gbase, voff) do { _Pragma("unroll") for (int _i = 0; _i < 2; ++_i) \
        __builtin_amdgcn_global_load_lds((const unsigned*)((const char*)(gbase) + (voff)[_i]), (LAS unsigned*)(lds + (bufoff) + ldsw + _i * 8192), 16, 0, 0); } while (0)
#define PG8_LDA(dst, b, h) do { _Pragma("unroll") for (int m = 0; m < 4; ++m) _Pragma("unroll") for (int k = 0; k < 2; ++k) dst[m][k] = *(const LAS bf16x8*)(lds + PG8_SA(b, h) + aoff + m * 2048 + k * 1024); } while (0)
#define PG8_LDB(dst, b, h) do { _Pragma("unroll") for (int n = 0; n < 2; ++n) _Pragma("unroll") for (int k = 0; k < 2; ++k) dst[n][k] = *(const LAS bf16x8*)(lds + PG8_SB(b, h) + boff + n * 2048 + k * 1024); } while (0)
#define PG8_MMA(ai, bj, At, Bt) do { __builtin_amdgcn_s_setprio(1); _Pragma("unroll") for (int m = 0; m < 4; ++m) _Pragma("unroll") for (int n = 0; n < 2; ++n) _Pragma("unroll") for (int k = 0; k < 2; ++k) \
        acc[ai][bj][m][n] = __builtin_amdgcn_mfma_f32_16x16x32_bf16(Bt[n][k], At[m][k], acc[ai][bj][m][n], 0, 0, 0); __builtin_amdgcn_s_setprio(0); } while (0)
#define PG8_WAIT_V(n) asm volatile("s_waitcnt vmcnt(" #n ")" ::: "memory")
#define PG8_WAIT_L(n) asm volatile("s_waitcnt lgkmcnt(" #n ")" ::: "memory")
#define PG8_BAR __builtin_amdgcn_s_barrier()
#define PG8_SCHED __builtin_amdgcn_sched_barrier(0)
    Unit cur, nxt; int ui = 0;
    if (!S.next(0, cur)) return;
    f32x4 acc[2][2][4][2];
#pragma unroll
    for (int a = 0; a < 2; ++a)
#pragma unroll
        for (int b = 0; b < 2; ++b)
#pragma unroll
            for (int m = 0; m < 4; ++m)
#pragma unroll
                for (int n = 0; n < 2; ++n) acc[a][b][m][n] = (f32x4){0.f, 0.f, 0.f, 0.f};
    bf16x8 At[4][2], B0[2][2], B1[2][2];
#define PG8_UA(u) ((u).kc < 0 ? (const char*)g.A + (size_t)(u).pm * tstepA : (const char*)g.A2 + (size_t)(u).pm * tstepA + (size_t)(u).kc * 1024)
#define PG8_UB(u) ((const char*)g.Bt + (size_t)(u).pn * tstepB + ((u).kc < 0 ? (size_t)0 : (size_t)(u).kc * 1024))
    const char* cA = PG8_UA(cur); const char* cB = PG8_UB(cur);
    PG8_STAGE(PG8_SB(0, 0), cB, voffB); PG8_STAGE(PG8_SB(0, 1), cB + hstepB, voffB); PG8_STAGE(PG8_SA(0, 0), cA, voffA); PG8_STAGE(PG8_SA(0, 1), cA + hstepA, voffA);
    if (wr == 1) PG8_BAR;
    PG8_WAIT_V(2); PG8_BAR;
    PG8_STAGE(PG8_SB(1, 0), cB + kstep, voffB); PG8_STAGE(PG8_SA(1, 0), cA + kstep, voffA); PG8_STAGE(PG8_SB(1, 1), cB + hstepB + kstep, voffB);
    PG8_WAIT_V(6); PG8_BAR;
    for (;;) {
        const bool has_next = S.next(ui + 1, nxt);
        const char* nA = has_next ? PG8_UA(nxt) : cA; const char* nB = has_next ? PG8_UB(nxt) : cB;
        const int ntu = cur.kc < 0 ? nt : 8;
        for (int t = 0; t < ntu; t += 2) {
            const bool last = (t == ntu - 2);
            const char* a1 = cA + (size_t)(t + 1) * kstep;
            const char* a2 = last ? nA : cA + (size_t)(t + 2) * kstep; const char* b2 = last ? nB : cB + (size_t)(t + 2) * kstep;
            const char* a3 = a2 + kstep; const char* b3 = b2 + kstep;
            PG8_LDB(B0, 0, 0); PG8_LDB(B1, 0, 1); PG8_SCHED; PG8_LDA(At, 0, 0); PG8_STAGE(PG8_SA(1, 1), a1 + hstepA, voffA);
            PG8_WAIT_V(8); PG8_WAIT_L(0); PG8_BAR; PG8_MMA(0, 0, At, B0); PG8_MMA(0, 1, At, B1); PG8_BAR; PG8_SCHED;
            PG8_LDA(At, 0, 1); PG8_STAGE(PG8_SB(0, 0), b2, voffB); PG8_STAGE(PG8_SB(0, 1), b2 + hstepB, voffB); PG8_STAGE(PG8_SA(0, 0), a2, voffA);
            PG8_WAIT_V(8); PG8_WAIT_L(0); PG8_BAR; PG8_MMA(1, 0, At, B0); PG8_MMA(1, 1, At, B1); PG8_BAR; PG8_SCHED;
            PG8_LDB(B0, 1, 0); PG8_LDB(B1, 1, 1); PG8_SCHED; PG8_LDA(At, 1, 0); PG8_STAGE(PG8_SA(0, 1), a2 + hstepA, voffA);
            PG8_WAIT_V(8); PG8_WAIT_L(0); PG8_BAR; PG8_MMA(0, 0, At, B0); PG8_MMA(0, 1, At, B1); PG8_BAR; PG8_SCHED;
            PG8_LDA(At, 1, 1); PG8_STAGE(PG8_SB(1, 0), b3, voffB); PG8_STAGE(PG8_SB(1, 1), b3 + hstepB, voffB); PG8_STAGE(PG8_SA(1, 0), a3, voffA);
            PG8_WAIT_V(8); PG8_WAIT_L(0); PG8_BAR; PG8_MMA(1, 0, At, B0); PG8_MMA(1, 1, At, B1); PG8_BAR; PG8_SCHED;
        }
        if (wr == 0) PG8_BAR;
        { const float* rp = cur.kc >= 0 ? rbs_tail : rbs;
          if (rp != nullptr) {
#pragma unroll
            for (int ai = 0; ai < 2; ++ai)
#pragma unroll
                for (int m = 0; m < 4; ++m) { const float rb = rsqrtf(rp[cur.pm * BM + ai * HALF + wr * 64 + m * 16 + fr] * (1.f / 2048.f) + EPS);
#pragma unroll
                    for (int bj = 0; bj < 2; ++bj)
#pragma unroll
                        for (int n = 0; n < 2; ++n) acc[ai][bj][m][n] = acc[ai][bj][m][n] * rb; } } }
        if (cur.kc >= 0) { EpiF32Perm E; E.C = g.P2 + (size_t)cur.kc * TCTX * 2048; E.ldc = 2048; E(acc, cur, wr, wc, fr, fq); }
        else if (mode == 0 && rvs != nullptr && ((cur.pn >= 24 && cur.pn < 32) || (cur.pn >= 40 && cur.pn < 48))) {
            const int j = cur.pn < 32 ? cur.pn - 24 : cur.pn - 32;
            bf16_t* O = (bf16_t*)Cout + ZC_U + 128 * j + wc * 32 + 8 * fq; const int row0 = cur.pm * BM + wr * 64 + fr;
#pragma unroll
            for (int ai = 0; ai < 2; ++ai)
#pragma unroll
                for (int m = 0; m < 4; ++m) { const f32x4 u0 = acc[ai][0][m][0], u1 = acc[ai][0][m][1], z0 = acc[ai][1][m][0], z1 = acc[ai][1][m][1];
                    u32x4 w; w.x = cvt_pk_bf16(u0[0] * silu_f(z0[0]), u0[1] * silu_f(z0[1])); w.y = cvt_pk_bf16(u0[2] * silu_f(z0[2]), u0[3] * silu_f(z0[3]));
                    w.z = cvt_pk_bf16(u1[0] * silu_f(z1[0]), u1[1] * silu_f(z1[1])); w.w = cvt_pk_bf16(u1[2] * silu_f(z1[2]), u1[3] * silu_f(z1[3]));
                    __builtin_nontemporal_store(w, (u32x4*)(O + (size_t)(row0 + ai * HALF + m * 16) * ldc)); } }
        else if (mode == 0) { EpiBf16 E; E.O = (bf16_t*)Cout; E.ldc = ldc; E(acc, cur, wr, wc, fr, fq);
            if (rvs != nullptr && (cur.pn >> 3) == 4) {
#pragma unroll
                for (int ai = 0; ai < 2; ++ai)
#pragma unroll
                    for (int m = 0; m < 4; ++m) { float ss = 0.f;
#pragma unroll
                        for (int bj = 0; bj < 2; ++bj)
#pragma unroll
                            for (int n = 0; n < 2; ++n) { const f32x4 v = acc[ai][bj][m][n]; ss += (v.x * v.x + v.y * v.y) + (v.z * v.z + v.w * v.w); }
                        ss += __shfl_xor(ss, 16); ss += __shfl_xor(ss, 32);
                        if (fq == 0) unsafeAtomicAdd(rvs + cur.pm * BM + ai * HALF + wr * 64 + m * 16 + fr, ss); } } }
        else { EpiF32 E; E.C = (float*)Cout; E.ldc = ldc; E(acc, cur, wr, wc, fr, fq); }
        if (!has_next) break;
#pragma unroll
        for (int a = 0; a < 2; ++a)
#pragma unroll
            for (int b = 0; b < 2; ++b)
#pragma unroll
                for (int m = 0; m < 4; ++m)
#pragma unroll
                    for (int n = 0; n < 2; ++n) acc[a][b][m][n] = (f32x4){0.f, 0.f, 0.f, 0.f};
        cur = nxt; cA = nA; cB = nB; ++ui;
        if (wr == 1) PG8_BAR;
    }
    PG8_WAIT_V(0);
    PG8_BAR;
#undef PG8_UA
#undef PG8_UB
#undef PG8_SA
#undef PG8_SB
#undef PG8_STAGE
#undef PG8_LDA
#undef PG8_LDB
#undef PG8_MMA
#undef PG8_WAIT_V
#undef PG8_WAIT_L
#undef PG8_BAR
#undef PG8_SCHED
}
}

#define XB_TMO      128
#define XB_XCNT(j)  (256  + 64 * (j))
#define XB_XSUB(j)  (1280 + 64 * (j))
#define XB_XGEN(j)  (2304 + 64 * (j))
#define XB_TOP      3328
#define XB_TOPGEN   3392
#define XCD_BAR_WORDS 3456
#define XB_SPIN_CAP (1u << 18)

__device__ __forceinline__ unsigned xb_ld(unsigned* p)              { return __hip_atomic_load(p, __ATOMIC_RELAXED, __HIP_MEMORY_SCOPE_AGENT); }
__device__ __forceinline__ unsigned xb_add(unsigned* p, unsigned v) { return __hip_atomic_fetch_add(p, v, __ATOMIC_RELAXED, __HIP_MEMORY_SCOPE_AGENT); }
__device__ __forceinline__ unsigned xb_xcc_id() { return (unsigned)__builtin_amdgcn_s_getreg((3 << 11) | 20) & 0xFu; }
#define XB_SPIN(cond, bar) do { unsigned _sp = 0; while (cond) { __builtin_amdgcn_s_sleep(1); \
    if ((++_sp & 255u) == 0u) { if (xb_ld(&(bar)[XB_TMO])) break; if (_sp > XB_SPIN_CAP) { atomicAdd(&(bar)[XB_TMO], 1u); break; } } } } while (0)

struct XcdBarrier {
    unsigned* bar; unsigned x;
    volatile LAS unsigned* st;
};

__device__ __forceinline__ XcdBarrier xcd_barrier_post(unsigned* bar, volatile LAS unsigned* st) {
    XcdBarrier b; b.bar = bar; b.x = xb_xcc_id(); b.st = st;
    if (threadIdx.x == 0) (void)xb_add(&bar[XB_XCNT(b.x)], 1u);
    return b;
}
__device__ __forceinline__ void xcd_barrier_complete(unsigned* bar, unsigned x, unsigned& nloc, unsigned& nx) {
    const unsigned G = gridDim.x * gridDim.y * gridDim.z;
    unsigned sum, cnt, mine, sp = 0u;
    for (;;) {
        sum = 0u; cnt = 0u; mine = 0u;
#pragma unroll
        for (unsigned j = 0; j < 16; ++j) { const unsigned c = xb_ld(&bar[XB_XCNT(j)]); sum += c; cnt += (c > 0u) ? 1u : 0u; mine = (j == x) ? c : mine; }
        if (sum == G) break;
        __builtin_amdgcn_s_sleep(1);
        if ((++sp & 255u) == 0u) { if (xb_ld(&bar[XB_TMO])) break; if (sp > XB_SPIN_CAP) { atomicAdd(&bar[XB_TMO], 1u); break; } }
    }
    nloc = mine > 0u ? mine : 1u; nx = cnt > 0u ? cnt : 1u;
}

__device__ __forceinline__ void xcd_barrier(const XcdBarrier& b) {
    asm volatile("s_waitcnt vmcnt(0)" ::: "memory");
    __syncthreads();
    if (threadIdx.x == 0) {
        unsigned* bar = b.bar;
        __builtin_amdgcn_s_waitcnt(0);
        unsigned nloc = b.st[0], nx = b.st[1];
        if (nloc == 0u) { xcd_barrier_complete(bar, b.x, nloc, nx); b.st[0] = nloc; b.st[1] = nx; }
        const unsigned old = xb_add(&bar[XB_XSUB(b.x)], 1u);
        const unsigned gen = old / nloc;
        if (old + 1u == (gen + 1u) * nloc) {
            __builtin_amdgcn_fence(__ATOMIC_RELEASE, "agent");
            asm volatile("s_waitcnt vmcnt(0)" ::: "memory");
            const unsigned og = xb_add(&bar[XB_TOP], 1u);
            const unsigned tg = og / nx;
            if (og + 1u == (tg + 1u) * nx) xb_add(&bar[XB_TOPGEN], 1u);
            else XB_SPIN(xb_ld(&bar[XB_TOPGEN]) == tg, bar);
            __builtin_amdgcn_fence(__ATOMIC_ACQUIRE, "agent");
            xb_add(&bar[XB_XGEN(b.x)], 1u);
            asm volatile("s_waitcnt vmcnt(0)" ::: "memory");
        } else {
            XB_SPIN(xb_ld(&bar[XB_XGEN(b.x)]) == gen, bar);
            __builtin_amdgcn_fence(__ATOMIC_ACQUIRE, "agent");
            asm volatile("s_waitcnt vmcnt(0)" ::: "memory");
        }
    }
    __syncthreads();
}


__device__ __forceinline__ void transpose_item(const float* W, int ldw, int srcc0, int k0, bf16_t* WT, int ldk, int n0, bool zero, LAS float* scr, int lane, const float* kscale = nullptr) {
    if (!zero) {
        f32x4 v[8];
#pragma unroll
        for (int i = 0; i < 8; ++i) { const int kk = (lane >> 3) + 8 * i; v[i] = __builtin_nontemporal_load((const f32x4*)(W + (size_t)(k0 + kk) * ldw + srcc0 + (lane & 7) * 4)); }
#pragma unroll
        for (int i = 0; i < 8; ++i) { const int kk = (lane >> 3) + 8 * i; LAS float* d = scr + kk * 33 + (lane & 7) * 4; const float sc = kscale ? kscale[kk] : 1.f; d[0] = v[i].x * sc; d[1] = v[i].y * sc; d[2] = v[i].z * sc; d[3] = v[i].w * sc; }
    }
    asm volatile("s_waitcnt lgkmcnt(0)" ::: "memory");
    const int c = lane & 7;
#pragma unroll
    for (int j = 0; j < 4; ++j) { const int n = (lane >> 3) + 8 * j; const LAS float* s = scr + (8 * c) * 33 + n;
        u32x4 o;
        if (zero) { o = (u32x4){0u, 0u, 0u, 0u}; }
        else { o.x = cvt_pk_bf16(s[0 * 33], s[1 * 33]); o.y = cvt_pk_bf16(s[2 * 33], s[3 * 33]); o.z = cvt_pk_bf16(s[4 * 33], s[5 * 33]); o.w = cvt_pk_bf16(s[6 * 33], s[7 * 33]); }
        *(u32x4*)(WT + (size_t)(n0 + n) * ldk + k0 + 8 * c) = o; }
    asm volatile("s_waitcnt lgkmcnt(0)" ::: "memory");
}

__device__ __forceinline__ void convert_layer_weights(const Args& a, unsigned char* ws, const int l, const int gw, const int NGW, LAS unsigned char* lds, const int wave, const int lane) {
    LAS float* scr = (LAS float*)(lds + wave * 16384);
    constexpr int I_IN = 32 * 392, I_OUT = 64 * 64;
    bf16_t* WinT = (bf16_t*)(ws + WS_WIN); bf16_t* WoutT = (bf16_t*)(ws + WS_WOUT);
    for (int it = gw; it < I_IN + I_OUT; it += NGW) {
        if (it < I_IN) {
            const int kb = it / 392, nb = it % 392, n0 = nb * 32;
            int src; bool zero = false;
            if (n0 < 4096) src = n0; else if (n0 < 6144) src = 4160 + (n0 - 4096);
            else if (n0 < 8192 || (n0 >= 10240 && n0 < 12288)) {
                const int rel = n0 < 8192 ? n0 - 6144 : n0 - 10240 + 2048, j = rel >> 8, cc = rel & 255; src = cc < 128 ? 6208 + 128 * j + cc : 10304 + 128 * j + (cc - 128); }
            else if (n0 < 10240) src = 8256 + (n0 - 8192); else if (n0 < 12352) src = 4096 + (n0 - 12288); else { src = 0; zero = true; }
            transpose_item(INP(8) + (size_t)l * 2048 * INW, INW, src, kb * 64, WinT + (size_t)l * ZW * 2048, 2048, n0, zero, scr, lane);
        } else {
            const int r = it - I_IN, kb = r / 64, nb = r % 64;
            transpose_item(INP(19) + (size_t)l * 4096 * 2048, 2048, nb * 32, kb * 64, WoutT + (size_t)l * 2048 * 4096, 4096, nb * 32, false, scr, lane, kb >= 32 ? INP(18) + l * 2048 + (kb * 64 - 2048) : (const float*)nullptr);
        }
    }
}

__device__ __forceinline__ void phase_prologue(const Args& a, unsigned char* ws, const int bid, LAS unsigned char* lds, int tid, int wave, int lane) {
    const int G = gridDim.x;
    {
        LAS float* sc = (LAS float*)lds;
        LAS float* part = (LAS float*)(lds + 40960);
        const float* c = INP(1); const float* cctx = INP(3);
        for (int i = tid; i < 5 * 2048; i += 512) { const int s = i >> 11, k = i & 2047; const float cv = s < 4 ? c[s * 2048 + k] : cctx[k]; sc[i] = silu_f(cv); }
        __syncthreads();
        float* mod = (float*)(ws + WS_MOD);
        for (int item = bid; item < 192; item += G) {
            const int l = item / 48, cb = item % 48, col0 = cb * 128;
            const float* W = INP(4) + (size_t)l * 2048 * 6144 + col0 + lane * 2;
            float acc[5][2];
#pragma unroll
            for (int s = 0; s < 5; ++s) { acc[s][0] = 0.f; acc[s][1] = 0.f; }
            const int k0 = wave * 256;
#pragma unroll 8
            for (int k = k0; k < k0 + 256; ++k) { const f32x2 w = __builtin_nontemporal_load((const f32x2*)(W + (size_t)k * 6144));
#pragma unroll
                for (int s = 0; s < 5; ++s) { const float sv = sc[s * 2048 + k]; acc[s][0] += sv * w.x; acc[s][1] += sv * w.y; } }
#pragma unroll
            for (int s = 0; s < 5; ++s) { part[(wave * 5 + s) * 128 + lane * 2] = acc[s][0]; part[(wave * 5 + s) * 128 + lane * 2 + 1] = acc[s][1]; }
            __syncthreads();
            for (int i = tid; i < 640; i += 512) { const int s = i >> 7, cc = i & 127; float v = INP(5)[l * 6144 + col0 + cc];
#pragma unroll
                for (int w = 0; w < 8; ++w) v += part[(w * 5 + s) * 128 + cc];
                const int col = col0 + cc;
                if (col >= 4096) v *= INP(7)[l * 2048 + col - 4096]; else if (col >= 2048) v = (1.f + v) * INP(6)[l * 2048 + col - 2048];
                mod[(size_t)(l * 5 + s) * 6144 + col] = v; }
            __syncthreads();
        }
    }
    {
        bf16_t* wsb = (bf16_t*)(ws + WS_WSB); const float* w_s = INP(16);
        for (int i = (bid * 512 + tid) * 4; i < 4 * 16 * 16384; i += G * 512 * 4) { const f32x4 v = *(const f32x4*)(w_s + i);
            u32x2 o; o.x = cvt_pk_bf16(v.x, v.y); o.y = cvt_pk_bf16(v.z, v.w); *(u32x2*)(wsb + i) = o; }
    }
    convert_layer_weights(a, ws, 0, bid * 8 + wave, G * 8, lds, wave, lane);
}

__device__ __forceinline__ void phase_A(const Args& a, unsigned char* ws, const int bid, int l, int wave, int lane) {
    const int gw = bid * 8 + wave, NGW = gridDim.x * 8;
    const float* mod = (const float*)(ws + WS_MOD);
    float* ctxall = (float*)(ws + WS_CTX);
    bf16_t* hx = (bf16_t*)(ws + WS_HX);
    const bf16_t* z = (const bf16_t*)(ws + WS_Z);
#pragma unroll 1
    for (int seg = (l == 4 ? 1 : 0); seg < 5; ++seg) {
        const int s = seg == 0 ? 4 : seg - 1, rbeg = seg == 0 ? 0 : TCTX + (seg - 1) * SEQ, rend = seg == 0 ? TCTX : rbeg + SEQ;
        f32x4 G2[8], S2[8], SH[8];
        if (l >= 1) { const float* gp = mod + (size_t)((l - 1) * 5 + s) * 6144 + 4096 + lane * 4;
#pragma unroll
            for (int j = 0; j < 8; ++j) G2[j] = *(const f32x4*)(gp + j * 256); }
        if (l < 4) { const float* sp = mod + (size_t)(l * 5 + s) * 6144 + lane * 4;
#pragma unroll
            for (int j = 0; j < 8; ++j) { SH[j] = *(const f32x4*)(sp + j * 256); S2[j] = *(const f32x4*)(sp + 2048 + j * 256); } }
#pragma unroll 1
        for (int r = rbeg + gw; r < rend; r += NGW) {
            if (l < 4 && lane == 0) { ((float*)(ws + WS_RVS))[r] = 0.f; ((float*)(ws + WS_YBS))[r] = 0.f; }
            const float* src; float* dst;
            if (r < TCTX) { dst = ctxall + (size_t)r * D; src = (l <= 1) ? INP(2) + (size_t)r * D : dst; }
            else { dst = a.out + (size_t)(r - TCTX) * D; src = (l <= 1) ? INP(0) + (size_t)(r - TCTX) * D : dst; }
            f32x4 xv[8];
#pragma unroll
            for (int j = 0; j < 8; ++j) xv[j] = __builtin_nontemporal_load((const f32x4*)(src + j * 256 + lane * 4));
            if (l >= 1) {
                const bf16_t* orow = z + (size_t)r * ZW;
                f32x4 ov[8]; float ss = 0.f;
                if (r < TCTX) {
                    const float* pp = (const float*)(ws + WS_XBC) + (size_t)r * 2048 + lane * 4;
#pragma unroll
                    for (int j = 0; j < 8; ++j) { f32x4 acc4 = *(const f32x4*)(pp + j * 256);
#pragma unroll
                        for (int kc = 1; kc < 8; ++kc) acc4 = acc4 + *(const f32x4*)(pp + (size_t)kc * TCTX * 2048 + j * 256);
                        ov[j] = acc4; }
                } else {
#pragma unroll
                    for (int j = 0; j < 8; ++j) { const u32x2 ob = __builtin_nontemporal_load((const u32x2*)(orow + j * 256 + lane * 4)); ov[j] = (f32x4){bflo(ob.x), bfhi(ob.x), bflo(ob.y), bfhi(ob.y)}; }
                }
#pragma unroll
                for (int j = 0; j < 8; ++j) ss += (ov[j].x * ov[j].x + ov[j].y * ov[j].y) + (ov[j].z * ov[j].z + ov[j].w * ov[j].w);
                const float ro = rsqrtf(wave_sum(ss) * (1.f / D) + EPS);
#pragma unroll
                for (int j = 0; j < 8; ++j) { xv[j] = xv[j] + G2[j] * (ov[j] * ro); *(f32x4*)(dst + j * 256 + lane * 4) = xv[j]; }
            }
            if (l < 4) {
                float ss = 0.f;
#pragma unroll
                for (int j = 0; j < 8; ++j) ss += (xv[j].x * xv[j].x + xv[j].y * xv[j].y) + (xv[j].z * xv[j].z + xv[j].w * xv[j].w);
                const float rx = rsqrtf(wave_sum(ss) * (1.f / D) + EPS);
#pragma unroll
                for (int j = 0; j < 8; ++j) { const int col = j * 256 + lane * 4;
                    const f32x4 hv = (xv[j] * rx) * S2[j] + SH[j];
                    u32x2 o; o.x = cvt_pk_bf16(hv.x, hv.y); o.y = cvt_pk_bf16(hv.z, hv.w);
                    *(u32x2*)(hx + (size_t)r * D + col) = o; }
            }
        }
    }
}

__device__ __forceinline__ void mlp_phase(const Args& a, unsigned char* ws, const int bid, int l, LAS unsigned char* lds, int tid, int wave, int lane) {
    bf16_t* z = (bf16_t*)(ws + WS_Z);
    const bf16_t* wsb = (const bf16_t*)(ws + WS_WSB) + (size_t)l * 16 * 16384;
    const float* rvs = (const float*)(ws + WS_RVS); float* ybs = (float*)(ws + WS_YBS);
    const float* g_v = INP(15) + l * 2048; const float* b_s = INP(17) + l * 16 * 128;
    LAS unsigned char* L_W = lds; LAS unsigned char* L_V = lds + 34816;
    const int fr = lane & 15, fq = lane >> 4, wr = wave >> 1, wc = wave & 1;
    const int G = gridDim.x;
    u32x4 tw[4], tv[4]; float trk[4]; f32x4 tg0, tg1;
    const bool wfixed = (G & 15) == 0;
#define MLP_ISSUE(it) do { const int _gc = (it) >> 4, _g = (it) & 15; \
        _Pragma("unroll") for (int i = 0; i < 4; ++i) { const int p = tid + i * 512, r = p >> 4, cp = p & 15; \
            if (!wfixed) tw[i] = *(const u32x4*)(wsb + (size_t)_g * 16384 + r * 128 + cp * 8); \
            tv[i] = __builtin_nontemporal_load((const u32x4*)(z + (size_t)(_gc * 128 + r) * ZW + ZC_V + _g * 128 + cp * 8)); \
            trk[i] = rvs[_gc * 128 + r]; } \
        tg0 = *(const f32x4*)(g_v + _g * 128 + (tid & 15) * 8); tg1 = *(const f32x4*)(g_v + _g * 128 + (tid & 15) * 8 + 4); } while (0)
    if (wfixed && bid < NCH * 16) {
#pragma unroll
        for (int i = 0; i < 4; ++i) { const int p = tid + i * 512, r = p >> 4, cp = p & 15; *(LAS u32x4*)(L_W + r * 272 + cp * 16) = *(const u32x4*)(wsb + (size_t)(bid & 15) * 16384 + r * 128 + cp * 8); } }
    if (bid < NCH * 16) MLP_ISSUE(bid);
#pragma unroll 1
    for (int it = bid; it < NCH * 16; it += G) {
        const int gc = it >> 4, g = it & 15, row0 = gc * 128;
#pragma unroll
        for (int i = 0; i < 4; ++i) { const int p = tid + i * 512, r = p >> 4, cp = p & 15;
            if (!wfixed) *(LAS u32x4*)(L_W + r * 272 + cp * 16) = tw[i];
            float f[8]; unpack8(tv[i], f); const float rk = rsqrtf(trk[i] * (1.f / 2048.f) + EPS);
            const f32x4 g0 = tg0, g1 = tg1;
            float o[8] = {f[0] * rk * g0.x, f[1] * rk * g0.y, f[2] * rk * g0.z, f[3] * rk * g0.w, f[4] * rk * g1.x, f[5] * rk * g1.y, f[6] * rk * g1.z, f[7] * rk * g1.w};
            *(LAS u32x4*)(L_V + offb(r, cp)) = pack8(o); }
        u32x4 pu[2][2]; float pbias[2];
#pragma unroll
        for (int i = 0; i < 2; ++i) { const int q = (2 * wr + i) * 16 + fr; const bf16_t* zr = z + (size_t)(row0 + q) * ZW; pbias[i] = b_s[g * 128 + q];
#pragma unroll
            for (int m = 0; m < 2; ++m) { const int d0 = g * 128 + 32 * (2 * wc + m) + 8 * fq; pu[i][m] = __builtin_nontemporal_load((const u32x4*)(zr + ZC_U + d0)); } }
        LDS_BARRIER();
        if (it + G < NCH * 16) MLP_ISSUE(it + G);
        f32x4 acc[2][4];
#pragma unroll
        for (int i = 0; i < 2; ++i)
#pragma unroll
            for (int j = 0; j < 4; ++j) acc[i][j] = (f32x4){0.f, 0.f, 0.f, 0.f};
#pragma unroll
        for (int s = 0; s < 4; ++s) { bf16x8 wf[2], vf[4];
#pragma unroll
            for (int i = 0; i < 2; ++i) wf[i] = *(const LAS bf16x8*)(L_W + ((2 * wr + i) * 16 + fr) * 272 + s * 64 + fq * 16);
#pragma unroll
            for (int j = 0; j < 4; ++j) vf[j] = ldfrag_tr_bp(L_V, 32 * s, 4 * wc + j, lane);
            __builtin_amdgcn_sched_barrier(0);
#pragma unroll
            for (int i = 0; i < 2; ++i)
#pragma unroll
                for (int j = 0; j < 4; ++j) acc[i][j] = MFMA16(vf[j], wf[i], acc[i][j]);
            __builtin_amdgcn_sched_barrier(0); }
#pragma unroll
        for (int i = 0; i < 2; ++i) { const int q = (2 * wr + i) * 16 + fr; const float bias = pbias[i];
            bf16_t* zr = z + (size_t)(row0 + q) * ZW; float ss = 0.f;
#pragma unroll
            for (int m = 0; m < 2; ++m) { const int d0 = g * 128 + 32 * (2 * wc + m) + 8 * fq;
                float uf[8]; unpack8(pu[i][m], uf);
                float o[8];
#pragma unroll
                for (int r = 0; r < 4; ++r) { o[r] = uf[r] * (acc[i][2 * m][r] + bias); o[4 + r] = uf[4 + r] * (acc[i][2 * m + 1][r] + bias); }
#pragma unroll
                for (int e = 0; e < 8; ++e) ss += o[e] * o[e];
                *(u32x4*)(zr + ZC_U + d0) = pack8(o); }
            ss += __shfl_xor(ss, 16); ss += __shfl_xor(ss, 32);
            if (fq == 0) unsafeAtomicAdd(ybs + row0 + q, ss); }
        LDS_BARRIER();
    }
#undef MLP_ISSUE
}

__device__ __forceinline__ void conv_stream(const Args& a, unsigned char* ws, const int bid, int l, int tid) {
    const bf16_t* z = (const bf16_t*)(ws + WS_Z); bf16_t* xbc = (bf16_t*)(ws + WS_XBC);
    const int c0 = tid * 8;
    const float* cw = INP(9) + (size_t)l * 5 * 4096 + c0; const float* cbias = INP(10) + l * 4096 + c0;
    float w[5][8], bias[8];
#pragma unroll
    for (int k = 0; k < 5; ++k) { const f32x4 w0 = *(const f32x4*)(cw + k * 4096), w1 = *(const f32x4*)(cw + k * 4096 + 4);
        w[k][0] = w0.x; w[k][1] = w0.y; w[k][2] = w0.z; w[k][3] = w0.w; w[k][4] = w1.x; w[k][5] = w1.y; w[k][6] = w1.z; w[k][7] = w1.w; }
    { const f32x4 b0 = *(const f32x4*)cbias, b1 = *(const f32x4*)(cbias + 4); bias[0] = b0.x; bias[1] = b0.y; bias[2] = b0.z; bias[3] = b0.w; bias[4] = b1.x; bias[5] = b1.y; bias[6] = b1.z; bias[7] = b1.w; }
    for (int tg = bid; tg < T / 8; tg += gridDim.x) {
        const int tb = tg * 8;
        bool lo_ok, hi_ok;
        if (tb < TCTX) { lo_ok = (tb & 255) != 0; hi_ok = ((tb + 8) & 255) != 0; }
        else { lo_ok = ((tb - TCTX) & 63) != 0; hi_ok = ((tb + 8 - TCTX) & 63) != 0; }
        u32x4 rows[12];
#pragma unroll
        for (int j = 0; j < 12; ++j) { const bool ok = (j >= 2 && j < 10) || (j < 2 && lo_ok) || (j >= 10 && hi_ok);
            rows[j] = ok ? __builtin_nontemporal_load((const u32x4*)(z + (size_t)(tb - 2 + j) * ZW + c0)) : (u32x4){0u, 0u, 0u, 0u}; }
#pragma unroll
        for (int e = 0; e < 8; ++e) { float acc[8];
#pragma unroll
            for (int c = 0; c < 8; ++c) acc[c] = bias[c];
#pragma unroll
            for (int k = 0; k < 5; ++k) { float f[8]; unpack8(rows[e + k], f);
#pragma unroll
                for (int c = 0; c < 8; ++c) acc[c] += w[k][c] * f[c]; }
#pragma unroll
            for (int c = 0; c < 8; ++c) acc[c] = silu_f(acc[c]);
            *(u32x4*)(xbc + (size_t)(tb + e) * 4096 + c0) = pack8(acc); }
    }
}

__device__ __forceinline__ void phase_C0(const Args& a, unsigned char* ws, const int bid, int l, LAS unsigned char* lds, int tid, int wave, int lane) {
    const int G = gridDim.x;
    { const bf16_t* z = (const bf16_t*)(ws + WS_Z); float* DT = (float*)(ws + WS_DT); const float* dtb = INP(11) + l * 64;
      for (int idx = bid * 512 + tid; idx < T * 64; idx += G * 512) { const int t = idx >> 6, j = idx & 63;
          const float xr = bf1(z[(size_t)t * ZW + ZC_DT + j]) + dtb[j];
          const float e = __expf(-fabsf(xr)), u = 1.f + e;
          const float l1p = (u == 1.f) ? e : __logf(u) * e * __builtin_amdgcn_rcpf(u - 1.f);
          DT[idx] = fmaxf(xr, 0.f) + l1p; } }
    mlp_phase(a, ws, bid, l, lds, tid, wave, lane);
    conv_stream(a, ws, bid, l, tid);
#ifdef CONV_REP
    conv_stream(a, ws, bid, l, tid);
#endif
}

__device__ __forceinline__ void phase_C1(const Args& a, unsigned char* ws, const int bid, int l, LAS unsigned char* lds, int tid, int wave, int lane) {
    bf16_t* z = (bf16_t*)(ws + WS_Z);
    const bf16_t* xbc = (const bf16_t*)(ws + WS_XBC);
    const float* DT = (const float*)(ws + WS_DT);
    LAS unsigned char* L_C = lds; LAS unsigned char* L_B = lds + 34816; LAS unsigned char* L_M = lds + 69632; LAS unsigned char* L_X = lds + 104448; LAS unsigned char* L_H = lds + 122880;
    LAS float* cs = (LAS float*)(lds + 140288); LAS float* dtv = cs + 128; LAS float* wgt = cs + 256; LAS float* ecs = cs + 384; LAS float* f2dt = cs + 512; LAS float* refarr = cs + 640; LAS float* totp = cs + 656;
    const int fr = lane & 15, fq = lane >> 4, wr = wave >> 1, wc = wave & 1;
    const int qt = wave < 4 ? wave : 11 - wave;
    const int rb = fr * 272 + fq * 16;
    const int trB = (8 * fq + (fr >> 2)) * 272 + 8 * (lane & 3);
    const int trX = (8 * fq + (fr >> 2)) * 144 + 8 * (lane & 3);
    const int trXp = (8 * fq + (fr >> 2)) * 144 + 16 * (lane & 3);
    const int rbH = (8 * (fr >> 2) + (fr & 3)) * 272 + fq * 16;
    const unsigned offCB = (unsigned)(tid >> 4) * 4096u + (unsigned)(tid & 15) * 8u, offX = (unsigned)(tid >> 3) * 4096u + (unsigned)(tid & 7) * 8u;
    const int wCB = (tid >> 4) * 272 + (tid & 15) * 16, wX = (tid >> 3) * 144 + (tid & 7) * 16;
#define TRB(base, krow0, col0, t) __builtin_amdgcn_ds_read_tr16_b64_v4i16((LAS s16x4*)((base) + trB + ((krow0) + 4 * (t)) * 272 + (col0) * 2))
#define TRX(base, krow0, col0, t) __builtin_amdgcn_ds_read_tr16_b64_v4i16((LAS s16x4*)((base) + trX + ((krow0) + 4 * (t)) * 144 + (col0) * 2))
    for (int item = bid; item < 256; item += gridDim.x) {
        const int combo = (item & 7) * 8 + (item >> 5), hq = (item >> 3) & 3;
        const int b = combo >> 4, g = (combo >> 1) & 7, dir = combo & 1, h = 4 * g + hq;
        const float Acoef = -__expf(INP(12)[l * 64 + dir * 32 + h]);
        const float dskip = INP(13)[l * 32 + h];
        f32x4 Hacc[4];
#pragma unroll
        for (int j = 0; j < 4; ++j) Hacc[j] = (f32x4){0.f, 0.f, 0.f, 0.f};
        for (int i = tid; i < 17408 / 4; i += 512) ((LAS unsigned*)L_H)[i] = 0u;
        u32x4 pc[4], pb[4], px[2]; float pd0 = 0.f, pd1 = 0.f;
#define SSD_GC(step) ((dir == 0) ? ((step) < 2 ? 2 * b + (step) : 8 + b * 64 + ((step) - 2)) : ((step) < 2 ? 2 * b + (1 - (step)) : 8 + b * 64 + (65 - (step))))
#define SSD_ISSUE(step) do { const int _r0 = SSD_GC(step) * 128; const bf16_t* _cb = xbc + (size_t)_r0 * 4096 + 2048 + g * 128; const bf16_t* _xb = xbc + (size_t)_r0 * 4096 + h * 64; \
            _Pragma("unroll") for (int i = 0; i < 4; ++i) { pc[i] = *(const u32x4*)(_cb + 1024 + (size_t)i * 32 * 4096 + offCB); pb[i] = *(const u32x4*)(_cb + (size_t)i * 32 * 4096 + offCB); } \
            _Pragma("unroll") for (int i = 0; i < 2; ++i) px[i] = __builtin_nontemporal_load((const u32x4*)(_xb + (size_t)i * 64 * 4096 + offX)); \
            if (wave == 0) { pd0 = DT[(size_t)(_r0 + 2 * lane) * 64 + dir * 32 + h]; pd1 = DT[(size_t)(_r0 + 2 * lane + 1) * 64 + dir * 32 + h]; } } while (0)
        SSD_ISSUE(0);
#pragma unroll 1
        for (int step = 0; step < 66; ++step) {
            const int row0 = SSD_GC(step) * 128;
#pragma unroll
            for (int i = 0; i < 4; ++i) { *(LAS u32x4*)(L_C + wCB + i * 32 * 272) = pc[i]; *(LAS u32x4*)(L_B + wCB + i * 32 * 272) = pb[i]; }
#pragma unroll
            for (int i = 0; i < 2; ++i) *(LAS u32x4*)(L_X + wX + i * 64 * 144) = px[i];
            if (wave == 0) {
                const int t0 = 2 * lane;
                const float d0 = pd0, d1 = pd1;
                const float a0 = d0 * Acoef, a1 = d1 * Acoef, pair = a0 + a1; const float incl = wave_incl_scan(pair);
                const float tot = __builtin_bit_cast(float, __builtin_amdgcn_readlane(__builtin_bit_cast(int, incl), 63)), excl = incl - pair;
                float c0v, c1v, ref;
                if (dir == 0) { c0v = excl + a0; c1v = incl; ref = __shfl(c1v, (lane & ~7) + 7); }
                else { c0v = tot - excl; c1v = tot - incl + a1; ref = __shfl(c0v, lane & ~7); }
                cs[t0] = c0v; cs[t0 + 1] = c1v; dtv[t0] = d0; dtv[t0 + 1] = d1;
                wgt[t0] = d0 * __expf(tot - c0v); wgt[t0 + 1] = d1 * __expf(tot - c1v);
                ecs[t0] = __expf(c0v); ecs[t0 + 1] = __expf(c1v);
                f2dt[t0] = d0 * __expf(ref - c0v); f2dt[t0 + 1] = d1 * __expf(ref - c1v);
                if ((lane & 7) == 0) refarr[lane >> 3] = ref;
                if (lane == 0) totp[0] = tot;
            }
            LDS_BARRIER();
            if (step + 1 < 66) SSD_ISSUE(step + 1);
            f32x4 accA[8], accC[4];
#pragma unroll
            for (int j = 0; j < 8; ++j) accA[j] = (f32x4){0.f, 0.f, 0.f, 0.f};
#pragma unroll
            for (int j = 0; j < 4; ++j) accC[j] = (f32x4){0.f, 0.f, 0.f, 0.f};
            {
                bf16x8 cqv[2], bq[2][4], hq[2][2];
#define SSD_LDH(buf, h_) do { const int _s = (h_) >> 1, _hf = (h_) & 1; if (_hf == 0) cqv[_s & 1] = *(const LAS bf16x8*)(L_C + qt * (16 * 272) + rb + _s * 64); \
                    _Pragma("unroll") for (int k = 0; k < 4; ++k) bq[buf][k] = *(const LAS bf16x8*)(L_B + (4 * _hf + k) * (16 * 272) + rb + _s * 64); \
                    _Pragma("unroll") for (int p = 0; p < 2; ++p) hq[buf][p] = *(const LAS bf16x8*)(L_H + (32 * _hf + 4 * p) * 272 + rbH + _s * 64); } while (0)
                SSD_LDH(0, 0);
#pragma unroll
                for (int h2 = 0; h2 < 8; ++h2) { const int cb = h2 & 1, s_ = h2 >> 1, hf_ = h2 & 1;
                    if (h2 < 7) SSD_LDH(cb ^ 1, h2 + 1);
                    __builtin_amdgcn_sched_barrier(0);
#pragma unroll
                    for (int k = 0; k < 4; ++k) accA[4 * hf_ + k] = MFMA16(bq[cb][k], cqv[s_ & 1], accA[4 * hf_ + k]);
#pragma unroll
                    for (int p = 0; p < 2; ++p) accC[2 * hf_ + p] = MFMA16(hq[cb][p], cqv[s_ & 1], accC[2 * hf_ + p]);
                    __builtin_amdgcn_sched_barrier(0); }
#undef SSD_LDH
            }
            { const float etot = __expf(totp[0]);
#pragma unroll
              for (int j = 0; j < 4; ++j) Hacc[j] = Hacc[j] * etot;
#pragma unroll
              for (int s = 0; s < 4; ++s) { const s16x4 xlo = TRX(L_X, 32 * s, 16 * wr, 0), xhi = TRX(L_X, 32 * s, 16 * wr, 1);
                  const f32x4 w0 = *(const LAS f32x4*)(wgt + s * 32 + fq * 8), w1 = *(const LAS f32x4*)(wgt + s * 32 + fq * 8 + 4);
                  s16x4 blo[4], bhi[4];
#pragma unroll
                  for (int j = 0; j < 4; ++j) { blo[j] = TRB(L_B, 32 * s, 16 * (4 * wc + j), 0); bhi[j] = TRB(L_B, 32 * s, 16 * (4 * wc + j), 1); }
                  __builtin_amdgcn_sched_barrier(0);
                  const u32x2 xl = __builtin_bit_cast(u32x2, xlo), xh = __builtin_bit_cast(u32x2, xhi);
                  u32x4 xs; xs.x = cvt_pk_bf16(bflo(xl.x) * w0.x, bfhi(xl.x) * w0.y); xs.y = cvt_pk_bf16(bflo(xl.y) * w0.z, bfhi(xl.y) * w0.w);
                  xs.z = cvt_pk_bf16(bflo(xh.x) * w1.x, bfhi(xh.x) * w1.y); xs.w = cvt_pk_bf16(bflo(xh.y) * w1.z, bfhi(xh.y) * w1.w);
                  const bf16x8 xq = __builtin_bit_cast(bf16x8, xs);
#pragma unroll
                  for (int j = 0; j < 4; ++j) { const bf16x8 bt = (bf16x8){blo[j].x, blo[j].y, blo[j].z, blo[j].w, bhi[j].x, bhi[j].y, bhi[j].z, bhi[j].w};
                      Hacc[j] = MFMA16(bt, xq, Hacc[j]); }
                  __builtin_amdgcn_sched_barrier(0); } }
            { const int q = qt * 16 + fr; const float csq = cs[q], eq = ecs[q];
              f32x4 gd = accA[0];
#pragma unroll
              for (int kt = 1; kt < 8; ++kt) { const bool is = (kt == qt); gd.x = is ? accA[kt].x : gd.x; gd.y = is ? accA[kt].y : gd.y; gd.z = is ? accA[kt].z : gd.z; gd.w = is ? accA[kt].w : gd.w; }
#pragma unroll
              for (int kt = 0; kt < 8; ++kt) { const int k0 = kt * 16 + fq * 4;
                  const bool kept = dir == 0 ? (kt < qt) : (kt > qt);
                  const float f1 = __expf(csq - refarr[kt]); const f32x4 f2 = *(const LAS f32x4*)(f2dt + k0);
                  float m[4];
#pragma unroll
                  for (int r = 0; r < 4; ++r) m[r] = kept ? accA[kt][r] * f1 * f2[r] : 0.f;
                  u32x2 o; o.x = cvt_pk_bf16(m[0], m[1]); o.y = cvt_pk_bf16(m[2], m[3]);
                  *(LAS u32x2*)(L_M + q * 272 + k0 * 2) = o; }
              { const int k0 = qt * 16 + fq * 4; const f32x4 ck = *(const LAS f32x4*)(cs + k0), dk = *(const LAS f32x4*)(dtv + k0); float m[4];
#pragma unroll
                for (int r = 0; r < 4; ++r) { const int kk = k0 + r; const bool keep = dir == 0 ? (kk <= q) : (kk >= q); m[r] = keep ? gd[r] * __expf(csq - ck[r]) * dk[r] : 0.f; }
                u32x2 o; o.x = cvt_pk_bf16(m[0], m[1]); o.y = cvt_pk_bf16(m[2], m[3]);
                *(LAS u32x2*)(L_M + q * 272 + k0 * 2) = o; }
              f32x4 accB[4];
#pragma unroll
              for (int j = 0; j < 4; ++j) accB[j] = (f32x4){0.f, 0.f, 0.f, 0.f};
#pragma unroll
              for (int s = 0; s < 4; ++s) { const bf16x8 mq = *(const LAS bf16x8*)(L_M + qt * (16 * 272) + rb + s * 64);
                  s16x4 xlo[4], xhi[4];
#pragma unroll
                  for (int pt = 0; pt < 4; ++pt) { xlo[pt] = __builtin_amdgcn_ds_read_tr16_b64_v4i16((LAS s16x4*)(L_X + trXp + (32 * s) * 144 + (32 * (pt >> 1) + 4 * (pt & 1)) * 2));
                      xhi[pt] = __builtin_amdgcn_ds_read_tr16_b64_v4i16((LAS s16x4*)(L_X + trXp + (32 * s + 4) * 144 + (32 * (pt >> 1) + 4 * (pt & 1)) * 2)); }
                  __builtin_amdgcn_sched_barrier(0);
#pragma unroll
                  for (int pt = 0; pt < 4; ++pt) { const bf16x8 xf = (bf16x8){xlo[pt].x, xlo[pt].y, xlo[pt].z, xlo[pt].w, xhi[pt].x, xhi[pt].y, xhi[pt].z, xhi[pt].w}; accB[pt] = MFMA16(xf, mq, accB[pt]); }
                  __builtin_amdgcn_sched_barrier(0); }
              bf16_t* yrow = z + (size_t)(row0 + q) * ZW + dir * 2048 + h * 64 + 8 * fq;
#pragma unroll
              for (int m = 0; m < 2; ++m) { float y[8];
#pragma unroll
                  for (int r = 0; r < 4; ++r) { y[r] = accB[2 * m][r] + eq * accC[2 * m][r]; y[4 + r] = accB[2 * m + 1][r] + eq * accC[2 * m + 1][r]; }
                  if (dir == 0) { const u32x4 xv = *(const LAS u32x4*)(L_X + q * 144 + (32 * m + 8 * fq) * 2); float xf8[8]; unpack8(xv, xf8);
#pragma unroll
                      for (int e = 0; e < 8; ++e) y[e] += dskip * xf8[e]; }
                  *(u32x4*)(yrow + 32 * m) = pack8(y); } }
            LDS_BARRIER();
#pragma unroll
            for (int j = 0; j < 4; ++j) { u32x2 o; o.x = cvt_pk_bf16(Hacc[j][0], Hacc[j][1]); o.y = cvt_pk_bf16(Hacc[j][2], Hacc[j][3]);
                *(LAS u32x2*)(L_H + (wr * 16 + fr) * 272 + ((4 * wc + j) * 16 + fq * 4) * 2) = o; }
        }
        __syncthreads();
#undef SSD_GC
#undef SSD_ISSUE
    }
#undef TRB
#undef TRX
}

__device__ __forceinline__ void phase_C2(const Args& a, unsigned char* ws, const int bid, int l, int wave, int lane) {
    bf16_t* z = (bf16_t*)(ws + WS_Z);
    const float* g_ssd = INP(14) + l * 2048; const float* g_mlp = INP(18) + l * 2048;
    const int gw = bid * 8 + wave, NGW = gridDim.x * 8;
    f32x4 gs[8];
#pragma unroll
    for (int j = 0; j < 4; ++j) { gs[2 * j] = *(const f32x4*)(g_ssd + j * 512 + lane * 8); gs[2 * j + 1] = *(const f32x4*)(g_ssd + j * 512 + lane * 8 + 4); }
    for (int r = gw + (l == 3 ? TCTX : 0); r < T; r += NGW) {
        bf16_t* zr = z + (size_t)r * ZW;
        const float ybr = ((const float*)(ws + WS_YBS))[r];
        float yv[32]; float ss = 0.f;
#pragma unroll
        for (int j = 0; j < 4; ++j) { const int col = j * 512 + lane * 8;
            const u32x4 yf = __builtin_nontemporal_load((const u32x4*)(zr + col)), yb = __builtin_nontemporal_load((const u32x4*)(zr + 2048 + col)), zs = __builtin_nontemporal_load((const u32x4*)(zr + ZC_ZSSD + col));
            float f0[8], f1[8], f2[8]; unpack8(yf, f0); unpack8(yb, f1); unpack8(zs, f2);
#pragma unroll
            for (int e = 0; e < 8; ++e) { const float y = (f0[e] + f1[e]) * silu_f(f2[e]); yv[j * 8 + e] = y; ss += y * y; } }
        const float ra = rsqrtf(wave_sum(ss) * (1.f / 2048.f) + EPS) * sqrtf(ybr * (1.f / 2048.f) + EPS);
#pragma unroll
        for (int j = 0; j < 4; ++j) { const int col = j * 512 + lane * 8;
            const f32x4 g0 = gs[2 * j], g1 = gs[2 * j + 1];
            float o[8] = {yv[j * 8 + 0] * ra * g0.x, yv[j * 8 + 1] * ra * g0.y, yv[j * 8 + 2] * ra * g0.z, yv[j * 8 + 3] * ra * g0.w,
                          yv[j * 8 + 4] * ra * g1.x, yv[j * 8 + 5] * ra * g1.y, yv[j * 8 + 6] * ra * g1.z, yv[j * 8 + 7] * ra * g1.w};
            *(u32x4*)(zr + ZC_ZSSD + col) = pack8(o); }
    }
}

__global__ void __launch_bounds__(512, 2) mk_fwd(Args a) {
    extern __shared__ __attribute__((aligned(16))) unsigned char lds_raw[];
    LAS unsigned char* lds = (LAS unsigned char*)lds_raw;
    cg::grid_group grid = cg::this_grid();
    { LAS unsigned* stw = (LAS unsigned*)(lds + LDS_BAR_OFF); if (threadIdx.x < 4) stw[threadIdx.x] = 0u; }
    __syncthreads();
    (void)xcd_barrier_post((unsigned*)(a.ws + WS_BAR), (volatile LAS unsigned*)(lds + LDS_BAR_OFF));
    int ph = a.ph_lo, rep = 0, nsync = 0; bool first = true;
#ifdef SYNC_PROBE
    for (int i = 0; i < 100; ++i) { XcdBarrier xb; xb.bar = (unsigned*)(a.ws + WS_BAR); xb.x = xb_xcc_id(); xb.st = (volatile LAS unsigned*)(lds + LDS_BAR_OFF); xcd_barrier(xb); }
#endif
#pragma unroll 1
    while (ph < a.ph_hi) {
        if (!first) { if (nsync == 0) grid.sync(); else { XcdBarrier xb; xb.bar = (unsigned*)(a.ws + WS_BAR); xb.x = xb_xcc_id(); xb.st = (volatile LAS unsigned*)(lds + LDS_BAR_OFF); xcd_barrier(xb); } ++nsync; }
        first = false;
        int tid = threadIdx.x; asm volatile("" : "+v"(tid));
        int bid = blockIdx.x; asm volatile("" : "+s"(bid));
        long zo = 0; asm volatile("" : "+s"(zo)); unsigned char* ws = a.ws + zo;
        const int wave = __builtin_amdgcn_readfirstlane(tid >> 6), lane = tid & 63;
        const int l = (ph - 1) / 6, sub = (ph - 1) % 6;
        if (ph == 0) phase_prologue(a, ws, bid, lds, tid, wave, lane);
        else if (sub == 0) phase_A(a, ws, bid, l, wave, lane);
        else if (sub == 1 || sub == 5) {
            pg8::Gemm g; void* cout; int ldc, mode;
            int tail = 0; g.A2 = nullptr; g.P2 = nullptr; const float* rbs = nullptr; const float* rbs_tail = nullptr;
            if (sub == 1) { g.A = (const bf16_t*)(ws + WS_HX); g.Bt = (const bf16_t*)(ws + WS_WIN) + (size_t)l * ZW * 2048; g.M = T; g.N = ZW; g.K = 2048; g.lda = 2048; cout = ws + WS_Z; ldc = ZW; mode = 0; }
            else { const int r0 = TCTX; rbs = (const float*)(ws + WS_YBS) + r0; rbs_tail = (const float*)(ws + WS_YBS);
                if (l < 3) { tail = 1; g.A2 = (const bf16_t*)(ws + WS_Z) + 4096; g.P2 = (float*)(ws + WS_XBC); }
                g.A = (const bf16_t*)(ws + WS_Z) + (size_t)r0 * ZW + 4096; g.Bt = (const bf16_t*)(ws + WS_WOUT) + (size_t)l * 2048 * 4096; g.M = T - r0; g.N = 2048; g.K = 4096; g.lda = ZW;
                cout = (bf16_t*)(ws + WS_Z) + (size_t)r0 * ZW; ldc = ZW; mode = 0; }
            pg8::StaticOrder S; S.init(g.M, g.N, (int)gridDim.x, bid, tail);
            pg8::gemm_phase(tid, lds, g, S, mode, cout, ldc, sub == 1 ? (float*)(ws + WS_RVS) : (float*)nullptr, rbs, rbs_tail);
            if (sub == 1 && l < 3) {
                const int nlong = (ZW / 256) * (T / 256) - ((ZW / 256) * (T / 256) / (int)gridDim.x) * (int)gridDim.x, G_ = (int)gridDim.x;
                if (nlong > 0 && nlong < G_) { if (bid >= nlong) convert_layer_weights(a, ws, l + 1, (bid - nlong) * 8 + wave, (G_ - nlong) * 8, lds, wave, lane); }
                else convert_layer_weights(a, ws, l + 1, bid * 8 + wave, G_ * 8, lds, wave, lane);
            }
        }
        else if (sub == 2) phase_C0(a, ws, bid, l, lds, tid, wave, lane);
        else if (sub == 3) phase_C1(a, ws, bid, l, lds, tid, wave, lane);
        else phase_C2(a, ws, bid, l, wave, lane);
        const int reps = ((ph > 0 && ((REP_MASK >> sub) & 1)) || (ph == 0 && (REP_MASK & 64)) || (ph > 0 && sub == 0 && l <= 1 && (REP_MASK & 128))) ? 2 : 1;
        if (++rep >= reps) { rep = 0; ++ph; }
    }
}

extern "C" void kernel_launch(void* const* d_in, const int* in_sizes, int n_in, void* d_out, int out_size, void* d_ws, size_t ws_size, hipStream_t stream) {
    static int grid = 0;
    if (grid == 0) {
        if (n_in != 20 || ws_size < WS_END) { fprintf(stderr, "kernel_launch: need 20 inputs and %zu bytes of workspace (got %d, %zu)\n", (size_t)WS_END, n_in, ws_size); grid = -1; return; }
        int dev = 0, cus = 0, per_cu = 0;
        hipGetDevice(&dev);
        hipDeviceGetAttribute(&cus, hipDeviceAttributeMultiprocessorCount, dev);
        hipFuncSetAttribute((const void*)mk_fwd, hipFuncAttributeMaxDynamicSharedMemorySize, LDS_BYTES);
        if (hipOccupancyMaxActiveBlocksPerMultiprocessor(&per_cu, (const void*)mk_fwd, 512, LDS_BYTES) != hipSuccess || per_cu < 1) per_cu = 1;
        (void)hipGetLastError();
        grid = cus * per_cu;
    }
    if (grid < 0) return;
    Args a{};
    for (int i = 0; i < 20; ++i) a.in[i] = (const float*)d_in[i];
    a.out = (float*)d_out; a.ws = (unsigned char*)d_ws; a.ph_lo = 0; a.ph_hi = 26;
    if (hipMemsetAsync((char*)d_ws + WS_BAR, 0, XCD_BAR_WORDS * sizeof(unsigned), stream) != hipSuccess) { fprintf(stderr, "kernel_launch: memset of the barrier words failed\n"); return; }
    void* args[] = {&a};
    hipError_t e = hipLaunchCooperativeKernel((const void*)mk_fwd, dim3(grid), dim3(512), args, LDS_BYTES, stream);
    if (e != hipSuccess) fprintf(stderr, "cooperative launch failed: %s (grid %d)\n", hipGetErrorString(e), grid);
}
```

```cpp
#include <hip/hip_runtime.h>
#include <hip/hip_cooperative_groups.h>
#include <cstdio>
#include <cstdint>
namespace cg = cooperative_groups;

#define LAS __attribute__((address_space(3)))
typedef unsigned short bf16_t;
typedef short bf16x8 __attribute__((ext_vector_type(8)));
typedef float f32x4 __attribute__((ext_vector_type(4)));
typedef float f32x2 __attribute__((ext_vector_type(2)));
typedef unsigned u32x4 __attribute__((ext_vector_type(4)));
typedef unsigned u32x2 __attribute__((ext_vector_type(2)));

constexpr int D = 2048, NB = 4, SEQ = 8192, DEPTH = 4, CTXL = 256;
constexpr int TCTX = NB * CTXL;
constexpr int T = TCTX + NB * SEQ;
constexpr int NCH = T / 128;
constexpr int ZW = 12544;
constexpr int ZC_ZSSD = 4096, ZC_U = 6144, ZC_V = 8192, ZC_ZMLP = 10240, ZC_DT = 12288;
constexpr int INW = 12352;
constexpr float EPS = 1e-6f;
constexpr int LDS_BAR_OFF = 161280;
constexpr int LDS_BYTES = 161296;
#ifndef REP_MASK
#define REP_MASK 0
#endif

constexpr size_t WS_BAR = 0;
constexpr size_t WS_MOD = 16384;
constexpr size_t WS_WSB = WS_MOD + 491520;
constexpr size_t WS_RVS = WS_WSB + 2097152;
constexpr size_t WS_YBS = WS_RVS + (size_t)T * 4;
constexpr size_t WS_DT = WS_YBS + (size_t)T * 4;
constexpr size_t WS_CTX = WS_DT + (size_t)T * 64 * 4;
constexpr size_t WS_WIN = WS_CTX + (size_t)TCTX * D * 4;
constexpr size_t WS_WOUT = WS_WIN + (size_t)4 * ZW * D * 2;
constexpr size_t WS_HX = WS_WOUT + (size_t)4 * 2048 * 4096 * 2;
constexpr size_t WS_Z = WS_HX + (size_t)T * D * 2;
constexpr size_t WS_XBC = WS_Z + (size_t)T * ZW * 2;
constexpr size_t WS_END = WS_XBC + (size_t)T * 4096 * 2;

struct Args { const float* in[20]; float* out; unsigned char* ws; int ph_lo, ph_hi; };

__device__ __forceinline__ unsigned cvt_pk_bf16(float lo, float hi) { unsigned r; asm volatile("v_cvt_pk_bf16_f32 %0, %1, %2" : "=v"(r) : "v"(lo), "v"(hi)); return r; }
__device__ __forceinline__ float bflo(unsigned u) { return __builtin_bit_cast(float, u << 16); }
__device__ __forceinline__ float bfhi(unsigned u) { return __builtin_bit_cast(float, u & 0xffff0000u); }
__device__ __forceinline__ float bf1(bf16_t h) { return __builtin_bit_cast(float, ((unsigned)h) << 16); }
template <int CTRL, int ROWMASK> __device__ __forceinline__ float dpp_get0(float v) { return __builtin_bit_cast(float, __builtin_amdgcn_update_dpp(0, __builtin_bit_cast(int, v), CTRL, ROWMASK, 0xf, true)); }
__device__ __forceinline__ float wave_incl_scan(float v) {
    v += dpp_get0<0x111, 0xf>(v); v += dpp_get0<0x112, 0xf>(v); v += dpp_get0<0x114, 0xf>(v); v += dpp_get0<0x118, 0xf>(v);
    v += dpp_get0<0x142, 0xa>(v);
    v += dpp_get0<0x143, 0xc>(v);
    return v;
}
__device__ __forceinline__ float wave_sum(float v) {
    return __builtin_bit_cast(float, __builtin_amdgcn_readlane(__builtin_bit_cast(int, wave_incl_scan(v)), 63));
}
__device__ __forceinline__ float silu_f(float x) { return x * __builtin_amdgcn_rcpf(1.f + __expf(-x)); }
__device__ __forceinline__ void unpack8(const u32x4 v, float* f) {
    f[0] = bflo(v.x); f[1] = bfhi(v.x); f[2] = bflo(v.y); f[3] = bfhi(v.y); f[4] = bflo(v.z); f[5] = bfhi(v.z); f[6] = bflo(v.w); f[7] = bfhi(v.w);
}
__device__ __forceinline__ u32x4 pack8(const float* f) {
    u32x4 w; w.x = cvt_pk_bf16(f[0], f[1]); w.y = cvt_pk_bf16(f[2], f[3]); w.z = cvt_pk_bf16(f[4], f[5]); w.w = cvt_pk_bf16(f[6], f[7]); return w;
}
__device__ __forceinline__ const float* inp_(const float* p) { long zo = 0; asm volatile("" : "+s"(zo)); return p + zo; }
#define INP(k) inp_(a.in[k])
typedef short s16x4 __attribute__((ext_vector_type(4)));
__device__ __forceinline__ bf16x8 ldfrag_tr(LAS const unsigned char* base, const int pitch, const int krow0, const int col0, const int lane) {
    const int g = lane >> 4, q = (lane & 15) >> 2, p = lane & 3;
    LAS const unsigned char* a0 = base + (krow0 + 8 * g + q) * pitch + (col0 + 4 * p) * 2;
    const s16x4 lo = __builtin_amdgcn_ds_read_tr16_b64_v4i16((LAS s16x4*)a0);
    const s16x4 hi = __builtin_amdgcn_ds_read_tr16_b64_v4i16((LAS s16x4*)(a0 + 4 * pitch));
    return (bf16x8){lo.x, lo.y, lo.z, lo.w, hi.x, hi.y, hi.z, hi.w};
}
__device__ __forceinline__ int offb(const int row, const int ch) { return 256 * row + 16 * (ch ^ (((row & 3) << 2) | ((row >> 2) & 3))); }
__device__ __forceinline__ int offx(const int row, const int ch) { return 128 * row + 16 * (ch ^ ((((row >> 1) & 1) << 1) | (((row >> 3) & 1) << 2))); }
__device__ __forceinline__ bf16x8 ldfrag_tr_b(LAS const unsigned char* base, const int krow0, const int c, const int lane) {
    const int g = lane >> 4, q = (lane & 15) >> 2, p = lane & 3, row = krow0 + 8 * g + q;
    const s16x4 lo = __builtin_amdgcn_ds_read_tr16_b64_v4i16((LAS s16x4*)(base + offb(row, 2 * c + (p >> 1)) + 8 * (p & 1)));
    const s16x4 hi = __builtin_amdgcn_ds_read_tr16_b64_v4i16((LAS s16x4*)(base + offb(row + 4, 2 * c + (p >> 1)) + 8 * (p & 1)));
    return (bf16x8){lo.x, lo.y, lo.z, lo.w, hi.x, hi.y, hi.z, hi.w};
}
__device__ __forceinline__ bf16x8 ldfrag_tr_bp(LAS const unsigned char* base, const int krow0, const int c, const int lane) {
    const int g = lane >> 4, q = (lane & 15) >> 2, p = lane & 3, row = krow0 + 8 * g + q, ch = 4 * (c >> 1) + p, b8 = 8 * (c & 1);
    const s16x4 lo = __builtin_amdgcn_ds_read_tr16_b64_v4i16((LAS s16x4*)(base + offb(row, ch) + b8));
    const s16x4 hi = __builtin_amdgcn_ds_read_tr16_b64_v4i16((LAS s16x4*)(base + offb(row + 4, ch) + b8));
    return (bf16x8){lo.x, lo.y, lo.z, lo.w, hi.x, hi.y, hi.z, hi.w};
}
__device__ __forceinline__ bf16x8 ldfrag_tr_x(LAS const unsigned char* base, const int krow0, const int c, const int lane) {
    const int g = lane >> 4, q = (lane & 15) >> 2, p = lane & 3, row = krow0 + 8 * g + q;
    LAS const unsigned char* a0 = base + offx(row, 2 * c + (p >> 1)) + 8 * (p & 1);
    const s16x4 lo = __builtin_amdgcn_ds_read_tr16_b64_v4i16((LAS s16x4*)a0);
    const s16x4 hi = __builtin_amdgcn_ds_read_tr16_b64_v4i16((LAS s16x4*)(a0 + 512));
    return (bf16x8){lo.x, lo.y, lo.z, lo.w, hi.x, hi.y, hi.z, hi.w};
}
#define LDS_BARRIER() do { asm volatile("s_waitcnt lgkmcnt(0)" ::: "memory"); __builtin_amdgcn_s_barrier(); asm volatile("" ::: "memory"); } while (0)
#define MFMA16(a, b, c) __builtin_amdgcn_mfma_f32_16x16x32_bf16((a), (b), (c), 0, 0, 0)

namespace pg8 {
constexpr int BM = 256, BK = 64, HALF = 128, HTB = HALF * BK * 2, STAGE_BYTES = 8 * HTB, NXCD = 8, WGM = 8;
__device__ __forceinline__ int lds_byte(int r, int c) { const int st = (r >> 4) * 2 + (c >> 5), rr = r & 15, cc = c & 31, ob = rr * 64 + cc * 2; return st * 1024 + (ob ^ (((ob >> 9) & 1) << 5)); }
__device__ __forceinline__ void stage_rc(int b, int& R, int& C) { const int st = b / 1024, sb = b % 1024, swz = sb ^ (((sb >> 9) & 1) << 5); R = (st >> 1) * 16 + swz / 64; C = (st & 1) * 32 + (swz % 64) / 2; }
__device__ __forceinline__ int perm32(int rho) { const int n = rho >> 4, i = rho & 15; return 8 * (i >> 2) + 4 * n + (i & 3); }
struct Unit { int pm, pn, kc; };
struct Gemm { const bf16_t* A; const bf16_t* Bt; int M, N, K, lda; const bf16_t* A2; float* P2; };
struct StaticOrder {
    int nM, nN, nwg, G, c, tail;
    __device__ void init(int M, int N, int G_, int c_, int tail_) { nM = M / BM; nN = N / BM; nwg = nM * nN; G = G_; c = c_; tail = tail_; }
    __device__ bool next(int i, Unit& u) const {
        const long L = (long)i * G + c;
        if (L >= nwg) { const long t = L - nwg; if (!tail || t >= 256) return false; u.pm = (int)(t >> 6); u.pn = (int)(t >> 3) & 7; u.kc = (int)t & 7; return true; }
        u.kc = -1;
        int wgid = (int)L; { const int q = nwg / NXCD, r = nwg % NXCD, xcd = wgid % NXCD, off = wgid / NXCD; wgid = (xcd < r ? xcd * (q + 1) : r * (q + 1) + (xcd - r) * q) + off; }
        const int nig = WGM * nN, gid = wgid / nig, fm = gid * WGM, gsz = (nM - fm) < WGM ? (nM - fm) : WGM;
        u.pm = fm + ((wgid % nig) % gsz); u.pn = (wgid % nig) / gsz; return true;
    }
};
struct EpiF32 {
    static constexpr bool PERM = false;
    float* C; int ldc;
    __device__ __forceinline__ void operator()(const f32x4 (&acc)[2][2][4][2], const Unit& u, int wr, int wc, int fr, int fq) const {
        const int row0 = u.pm * BM + wr * 64 + fr, col0 = u.pn * BM + wc * 32 + 4 * fq;
#pragma unroll
        for (int ai = 0; ai < 2; ++ai)
#pragma unroll
            for (int m = 0; m < 4; ++m) { float* rowp = C + (size_t)(row0 + ai * HALF + m * 16) * ldc + col0;
#pragma unroll
                for (int bj = 0; bj < 2; ++bj)
#pragma unroll
                    for (int n = 0; n < 2; ++n) *(f32x4*)(rowp + bj * HALF + n * 16) = acc[ai][bj][m][n]; }
    }
};
struct EpiF32Perm {
    float* C; int ldc;
    __device__ __forceinline__ void operator()(const f32x4 (&acc)[2][2][4][2], const Unit& u, int wr, int wc, int fr, int fq) const {
        const int row0 = u.pm * BM + wr * 64 + fr, col0 = u.pn * BM + wc * 32 + 8 * fq;
#pragma unroll
        for (int ai = 0; ai < 2; ++ai)
#pragma unroll
            for (int m = 0; m < 4; ++m) { float* rowp = C + (size_t)(row0 + ai * HALF + m * 16) * ldc + col0;
#pragma unroll
                for (int bj = 0; bj < 2; ++bj) { *(f32x4*)(rowp + bj * HALF) = acc[ai][bj][m][0]; *(f32x4*)(rowp + bj * HALF + 4) = acc[ai][bj][m][1]; } }
    }
};
struct EpiBf16 {
    static constexpr bool PERM = true;
    bf16_t* O; int ldc;
    __device__ __forceinline__ void operator()(const f32x4 (&acc)[2][2][4][2], const Unit& u, int wr, int wc, int fr, int fq) const {
        const int row0 = u.pm * BM + wr * 64 + fr, col0 = u.pn * BM + wc * 32 + 8 * fq;
#pragma unroll
        for (int ai = 0; ai < 2; ++ai)
#pragma unroll
            for (int m = 0; m < 4; ++m) { bf16_t* rowp = O + (size_t)(row0 + ai * HALF + m * 16) * ldc + col0;
#pragma unroll
                for (int bj = 0; bj < 2; ++bj) { const f32x4 v0 = acc[ai][bj][m][0], v1 = acc[ai][bj][m][1];
                    u32x4 w; w.x = cvt_pk_bf16(v0[0], v0[1]); w.y = cvt_pk_bf16(v0[2], v0[3]); w.z = cvt_pk_bf16(v1[0], v1[1]); w.w = cvt_pk_bf16(v1[2], v1[3]);
                    __builtin_nontemporal_store(w, (u32x4*)(rowp + bj * HALF)); } }
    }
};

__device__ __forceinline__ void gemm_phase(const int tid, LAS unsigned char* lds, const Gemm g, const StaticOrder& S, const int mode  , void* Cout, const int ldc, float* rvs, const float* rbs, const float* rbs_tail) {
    const int wid = __builtin_amdgcn_readfirstlane(tid >> 6), lane = tid & 63, wr = wid >> 2, wc = wid & 3, fr = lane & 15, fq = lane >> 4;
    const int K = g.K, nt = K / BK, lda = g.lda;
    unsigned voffA[2], voffB[2];
#pragma unroll
    for (int i = 0; i < 2; ++i) { int R, C; stage_rc(tid * 16 + i * 8192, R, C); const int Rb = (mode == 0) ? ((R & ~31) + perm32(R & 31)) : R;
        voffA[i] = (unsigned)(R * lda + C) * 2u; voffB[i] = (unsigned)(Rb * K + C) * 2u; }
    const size_t kstep = (size_t)(BK * 2);
    const size_t hstepA = (size_t)HALF * lda * 2, hstepB = (size_t)HALF * K * 2;
    const size_t tstepA = 2 * hstepA, tstepB = 2 * hstepB;
    const unsigned ldsw = (unsigned)wid * 1024u;
    const int aoff = lds_byte(wr * 64 + fr, fq * 8), boff = lds_byte(wc * 32 + fr, fq * 8);
#define PG8_SA(b, h) (((b) * 2 + (h)) * HTB)
#define PG8_SB(b, h) ((4 + (b) * 2 + (h)) * HTB)
#define PG8_STAGE(bufoff, gbase, voff) do { _Pragma("unroll") for (int _i = 0; _i < 2; ++_i) \
        __builtin_amdgcn_global_load_lds((const unsigned*)((const char*)(gbase) + (voff)[_i]), (LAS unsigned*)(lds + (bufoff) + ldsw + _i * 8192), 16, 0, 0); } while (0)
#define PG8_LDA(dst, b, h) do { _Pragma("unroll") for (int m = 0; m < 4; ++m) _Pragma("unroll") for (int k = 0; k < 2; ++k) dst[m][k] = *(const LAS bf16x8*)(lds + PG8_SA(b, h) + aoff + m * 2048 + k * 1024); } while (0)
#define PG8_LDB(dst, b, h) do { _Pragma("unroll") for (int n = 0; n < 2; ++n) _Pragma("unroll") for (int k = 0; k < 2; ++k) dst[n][k] = *(const LAS bf16x8*)(lds + PG8_SB(b, h) + boff + n * 2048 + k * 1024); } while (0)
#define PG8_MMA(ai, bj, At, Bt) do { __builtin_amdgcn_s_setprio(1); _Pragma("unroll") for (int m = 0; m < 4; ++m) _Pragma("unroll") for (int n = 0; n < 2; ++n) _Pragma("unroll") for (int k = 0; k < 2; ++k) \
        acc[ai][bj][m][n] = __builtin_amdgcn_mfma_f32_16x16x32_bf16(Bt[n][k], At[m][k], acc[ai][bj][m][n], 0, 0, 0); __builtin_amdgcn_s_setprio(0); } while (0)
#define PG8_WAIT_V(n) asm volatile("s_waitcnt vmcnt(" #n ")" ::: "memory")
#define PG8_WAIT_L(n) asm volatile("s_waitcnt lgkmcnt(" #n ")" ::: "memory")
#define PG8_BAR __builtin_amdgcn_s_barrier()
#define PG8_SCHED __builtin_amdgcn_sched_barrier(0)
    Unit cur, nxt; int ui = 0;
    if (!S.next(0, cur)) return;
    f32x4 acc[2][2][4][2];
#pragma unroll
    for (int a = 0; a < 2; ++a)
#pragma unroll
        for (int b = 0; b < 2; ++b)
#pragma unroll
            for (int m = 0; m < 4; ++m)
#pragma unroll
                for (int n = 0; n < 2; ++n) acc[a][b][m][n] = (f32x4){0.f, 0.f, 0.f, 0.f};
    bf16x8 At[4][2], B0[2][2], B1[2][2];
#define PG8_UA(u) ((u).kc < 0 ? (const char*)g.A + (size_t)(u).pm * tstepA : (const char*)g.A2 + (size_t)(u).pm * tstepA + (size_t)(u).kc * 1024)
#define PG8_UB(u) ((const char*)g.Bt + (size_t)(u).pn * tstepB + ((u).kc < 0 ? (size_t)0 : (size_t)(u).kc * 1024))
    const char* cA = PG8_UA(cur); const char* cB = PG8_UB(cur);
    PG8_STAGE(PG8_SB(0, 0), cB, voffB); PG8_STAGE(PG8_SB(0, 1), cB + hstepB, voffB); PG8_STAGE(PG8_SA(0, 0), cA, voffA); PG8_STAGE(PG8_SA(0, 1), cA + hstepA, voffA);
    if (wr == 1) PG8_BAR;
    PG8_WAIT_V(2); PG8_BAR;
    PG8_STAGE(PG8_SB(1, 0), cB + kstep, voffB); PG8_STAGE(PG8_SA(1, 0), cA + kstep, voffA); PG8_STAGE(PG8_SB(1, 1), cB + hstepB + kstep, voffB);
    PG8_WAIT_V(6); PG8_BAR;
    for (;;) {
        const bool has_next = S.next(ui + 1, nxt);
        const char* nA = has_next ? PG8_UA(nxt) : cA; const char* nB = has_next ? PG8_UB(nxt) : cB;
        const int ntu = cur.kc < 0 ? nt : 8;
        for (int t = 0; t < ntu; t += 2) {
            const bool last = (t == ntu - 2);
            const char* a1 = cA + (size_t)(t + 1) * kstep;
            const char* a2 = last ? nA : cA + (size_t)(t + 2) * kstep; const char* b2 = last ? nB : cB + (size_t)(t + 2) * kstep;
            const char* a3 = a2 + kstep; const char* b3 = b2 + kstep;
            PG8_LDB(B0, 0, 0); PG8_LDB(B1, 0, 1); PG8_SCHED; PG8_LDA(At, 0, 0); PG8_STAGE(PG8_SA(1, 1), a1 + hstepA, voffA);
            PG8_WAIT_V(8); PG8_WAIT_L(0); PG8_BAR; PG8_MMA(0, 0, At, B0); PG8_MMA(0, 1, At, B1); PG8_BAR; PG8_SCHED;
            PG8_LDA(At, 0, 1); PG8_STAGE(PG8_SB(0, 0), b2, voffB); PG8_STAGE(PG8_SB(0, 1), b2 + hstepB, voffB); PG8_STAGE(PG8_SA(0, 0), a2, voffA);
            PG8_WAIT_V(8); PG8_WAIT_L(0); PG8_BAR; PG8_MMA(1, 0, At, B0); PG8_MMA(1, 1, At, B1); PG8_BAR; PG8_SCHED;
            PG8_LDB(B0, 1, 0); PG8_LDB(B1, 1, 1); PG8_SCHED; PG8_LDA(At, 1, 0); PG8_STAGE(PG8_SA(0, 1), a2 + hstepA, voffA);
            PG8_WAIT_V(8); PG8_WAIT_L(0); PG8_BAR; PG8_MMA(0, 0, At, B0); PG8_MMA(0, 1, At, B1); PG8_BAR; PG8_SCHED;
            PG8_LDA(At, 1, 1); PG8_STAGE(PG8_SB(1, 0), b3, voffB); PG8_STAGE(PG8_SB(1, 1), b3 + hstepB, voffB); PG8_STAGE(PG8_SA(1, 0), a3, voffA);
            PG8_WAIT_V(8); PG8_WAIT_L(0); PG8_BAR; PG8_MMA(1, 0, At, B0); PG8_MMA(1, 1, At, B1); PG8_BAR; PG8_SCHED;
        }
        if (wr == 0) PG8_BAR;
        { const float* rp = cur.kc >= 0 ? rbs_tail : rbs;
          if (rp != nullptr) {
#pragma unroll
            for (int ai = 0; ai < 2; ++ai)
#pragma unroll
                for (int m = 0; m < 4; ++m) { const float rb = rsqrtf(rp[cur.pm * BM + ai * HALF + wr * 64 + m * 16 + fr] * (1.f / 2048.f) + EPS);
#pragma unroll
                    for (int bj = 0; bj < 2; ++bj)
#pragma unroll
                        for (int n = 0; n < 2; ++n) acc[ai][bj][m][n] = acc[ai][bj][m][n] * rb; } } }
        if (cur.kc >= 0) { EpiF32Perm E; E.C = g.P2 + (size_t)cur.kc * TCTX * 2048; E.ldc = 2048; E(acc, cur, wr, wc, fr, fq); }
        else if (mode == 0 && rvs != nullptr && ((cur.pn >= 24 && cur.pn < 32) || (cur.pn >= 40 && cur.pn < 48))) {
            const int j = cur.pn < 32 ? cur.pn - 24 : cur.pn - 32;
            bf16_t* O = (bf16_t*)Cout + ZC_U + 128 * j + wc * 32 + 8 * fq; const int row0 = cur.pm * BM + wr * 64 + fr;
#pragma unroll
            for (int ai = 0; ai < 2; ++ai)
#pragma unroll
                for (int m = 0; m < 4; ++m) { const f32x4 u0 = acc[ai][0][m][0], u1 = acc[ai][0][m][1], z0 = acc[ai][1][m][0], z1 = acc[ai][1][m][1];
                    u32x4 w; w.x = cvt_pk_bf16(u0[0] * silu_f(z0[0]), u0[1] * silu_f(z0[1])); w.y = cvt_pk_bf16(u0[2] * silu_f(z0[2]), u0[3] * silu_f(z0[3]));
                    w.z = cvt_pk_bf16(u1[0] * silu_f(z1[0]), u1[1] * silu_f(z1[1])); w.w = cvt_pk_bf16(u1[2] * silu_f(z1[2]), u1[3] * silu_f(z1[3]));
                    __builtin_nontemporal_store(w, (u32x4*)(O + (size_t)(row0 + ai * HALF + m * 16) * ldc)); } }
        else if (mode == 0) { EpiBf16 E; E.O = (bf16_t*)Cout; E.ldc = ldc; E(acc, cur, wr, wc, fr, fq);
            if (rvs != nullptr && (cur.pn >> 3) == 4) {
#pragma unroll
                for (int ai = 0; ai < 2; ++ai)
#pragma unroll
                    for (int m = 0; m < 4; ++m) { float ss = 0.f;
#pragma unroll
                        for (int bj = 0; bj < 2; ++bj)
#pragma unroll
                            for (int n = 0; n < 2; ++n) { const f32x4 v = acc[ai][bj][m][n]; ss += (v.x * v.x + v.y * v.y) + (v.z * v.z + v.w * v.w); }
                        ss += __shfl_xor(ss, 16); ss += __shfl_xor(ss, 32);
                        if (fq == 0) unsafeAtomicAdd(rvs + cur.pm * BM + ai * HALF + wr * 64 + m * 16 + fr, ss); } } }
        else { EpiF32 E; E.C = (float*)Cout; E.ldc = ldc; E(acc, cur, wr, wc, fr, fq); }
        if (!has_next) break;
#pragma unroll
        for (int a = 0; a < 2; ++a)
#pragma unroll
            for (int b = 0; b < 2; ++b)
#pragma unroll
                for (int m = 0; m < 4; ++m)
#pragma unroll
                    for (int n = 0; n < 2; ++n) acc[a][b][m][n] = (f32x4){0.f, 0.f, 0.f, 0.f};
        cur = nxt; cA = nA; cB = nB; ++ui;
        if (wr == 1) PG8_BAR;
    }
    PG8_WAIT_V(0);
    PG8_BAR;
#undef PG8_UA
#undef PG8_UB
#undef PG8_SA
#undef PG8_SB
#undef PG8_STAGE
#undef PG8_LDA
#undef PG8_LDB
#undef PG8_MMA
#undef PG8_WAIT_V
#undef PG8_WAIT_L
#undef PG8_BAR
#undef PG8_SCHED
}
}

#define XB_TMO      128
#define XB_XCNT(j)  (256  + 64 * (j))
#define XB_XSUB(j)  (1280 + 64 * (j))
#define XB_XGEN(j)  (2304 + 64 * (j))
#define XB_TOP      3328
#define XB_TOPGEN   3392
#define XCD_BAR_WORDS 3456
#define XB_SPIN_CAP (1u << 18)

__device__ __forceinline__ unsigned xb_ld(unsigned* p)              { return __hip_atomic_load(p, __ATOMIC_RELAXED, __HIP_MEMORY_SCOPE_AGENT); }
__device__ __forceinline__ unsigned xb_add(unsigned* p, unsigned v) { return __hip_atomic_fetch_add(p, v, __ATOMIC_RELAXED, __HIP_MEMORY_SCOPE_AGENT); }
__device__ __forceinline__ unsigned xb_xcc_id() { return (unsigned)__builtin_amdgcn_s_getreg((3 << 11) | 20) & 0xFu; }
#define XB_SPIN(cond, bar) do { unsigned _sp = 0; while (cond) { __builtin_amdgcn_s_sleep(1); \
    if ((++_sp & 255u) == 0u) { if (xb_ld(&(bar)[XB_TMO])) break; if (_sp > XB_SPIN_CAP) { atomicAdd(&(bar)[XB_TMO], 1u); break; } } } } while (0)

struct XcdBarrier {
    unsigned* bar; unsigned x;
    volatile LAS unsigned* st;
};

__device__ __forceinline__ XcdBarrier xcd_barrier_post(unsigned* bar, volatile LAS unsigned* st) {
    XcdBarrier b; b.bar = bar; b.x = xb_xcc_id(); b.st = st;
    if (threadIdx.x == 0) (void)xb_add(&bar[XB_XCNT(b.x)], 1u);
    return b;
}
__device__ __forceinline__ void xcd_barrier_complete(unsigned* bar, unsigned x, unsigned& nloc, unsigned& nx) {
    const unsigned G = gridDim.x * gridDim.y * gridDim.z;
    unsigned sum, cnt, mine, sp = 0u;
    for (;;) {
        sum = 0u; cnt = 0u; mine = 0u;
#pragma unroll
        for (unsigned j = 0; j < 16; ++j) { const unsigned c = xb_ld(&bar[XB_XCNT(j)]); sum += c; cnt += (c > 0u) ? 1u : 0u; mine = (j == x) ? c : mine; }
        if (sum == G) break;
        __builtin_amdgcn_s_sleep(1);
        if ((++sp & 255u) == 0u) { if (xb_ld(&bar[XB_TMO])) break; if (sp > XB_SPIN_CAP) { atomicAdd(&bar[XB_TMO], 1u); break; } }
    }
    nloc = mine > 0u ? mine : 1u; nx = cnt > 0u ? cnt : 1u;
}

__device__ __forceinline__ void xcd_barrier(const XcdBarrier& b) {
    asm volatile("s_waitcnt vmcnt(0)" ::: "memory");
    __syncthreads();
    if (threadIdx.x == 0) {
        unsigned* bar = b.bar;
        __builtin_amdgcn_s_waitcnt(0);
        unsigned nloc = b.st[0], nx = b.st[1];
        if (nloc == 0u) { xcd_barrier_complete(bar, b.x, nloc, nx); b.st[0] = nloc; b.st[1] = nx; }
        const unsigned old = xb_add(&bar[XB_XSUB(b.x)], 1u);
        const unsigned gen = old / nloc;
        if (old + 1u == (gen + 1u) * nloc) {
            __builtin_amdgcn_fence(__ATOMIC_RELEASE, "agent");
            asm volatile("s_waitcnt vmcnt(0)" ::: "memory");
            const unsigned og = xb_add(&bar[XB_TOP], 1u);
            const unsigned tg = og / nx;
            if (og + 1u == (tg + 1u) * nx) xb_add(&bar[XB_TOPGEN], 1u);
            else XB_SPIN(xb_ld(&bar[XB_TOPGEN]) == tg, bar);
            __builtin_amdgcn_fence(__ATOMIC_ACQUIRE, "agent");
            xb_add(&bar[XB_XGEN(b.x)], 1u);
            asm volatile("s_waitcnt vmcnt(0)" ::: "memory");
        } else {
            XB_SPIN(xb_ld(&bar[XB_XGEN(b.x)]) == gen, bar);
            __builtin_amdgcn_fence(__ATOMIC_ACQUIRE, "agent");
            asm volatile("s_waitcnt vmcnt(0)" ::: "memory");
        }
    }
    __syncthreads();
}


__device__ __forceinline__ void transpose_item(const float* W, int ldw, int srcc0, int k0, bf16_t* WT, int ldk, int n0, bool zero, LAS float* scr, int lane, const float* kscale = nullptr) {
    if (!zero) {
        f32x4 v[8];
#pragma unroll
        for (int i = 0; i < 8; ++i) { const int kk = (lane >> 3) + 8 * i; v[i] = __builtin_nontemporal_load((const f32x4*)(W + (size_t)(k0 + kk) * ldw + srcc0 + (lane & 7) * 4)); }
#pragma unroll
        for (int i = 0; i < 8; ++i) { const int kk = (lane >> 3) + 8 * i; LAS float* d = scr + kk * 33 + (lane & 7) * 4; const float sc = kscale ? kscale[kk] : 1.f; d[0] = v[i].x * sc; d[1] = v[i].y * sc; d[2] = v[i].z * sc; d[3] = v[i].w * sc; }
    }
    asm volatile("s_waitcnt lgkmcnt(0)" ::: "memory");
    const int c = lane & 7;
#pragma unroll
    for (int j = 0; j < 4; ++j) { const int n = (lane >> 3) + 8 * j; const LAS float* s = scr + (8 * c) * 33 + n;
        u32x4 o;
        if (zero) { o = (u32x4){0u, 0u, 0u, 0u}; }
        else { o.x = cvt_pk_bf16(s[0 * 33], s[1 * 33]); o.y = cvt_pk_bf16(s[2 * 33], s[3 * 33]); o.z = cvt_pk_bf16(s[4 * 33], s[5 * 33]); o.w = cvt_pk_bf16(s[6 * 33], s[7 * 33]); }
        *(u32x4*)(WT + (size_t)(n0 + n) * ldk + k0 + 8 * c) = o; }
    asm volatile("s_waitcnt lgkmcnt(0)" ::: "memory");
}

__device__ __forceinline__ void convert_layer_weights(const Args& a, unsigned char* ws, const int l, const int gw, const int NGW, LAS unsigned char* lds, const int wave, const int lane) {
    LAS float* scr = (LAS float*)(lds + wave * 16384);
    constexpr int I_IN = 32 * 392, I_OUT = 64 * 64;
    bf16_t* WinT = (bf16_t*)(ws + WS_WIN); bf16_t* WoutT = (bf16_t*)(ws + WS_WOUT);
    for (int it = gw; it < I_IN + I_OUT; it += NGW) {
        if (it < I_IN) {
            const int kb = it / 392, nb = it % 392, n0 = nb * 32;
            int src; bool zero = false;
            if (n0 < 4096) src = n0; else if (n0 < 6144) src = 4160 + (n0 - 4096);
            else if (n0 < 8192 || (n0 >= 10240 && n0 < 12288)) {
                const int rel = n0 < 8192 ? n0 - 6144 : n0 - 10240 + 2048, j = rel >> 8, cc = rel & 255; src = cc < 128 ? 6208 + 128 * j + cc : 10304 + 128 * j + (cc - 128); }
            else if (n0 < 10240) src = 8256 + (n0 - 8192); else if (n0 < 12352) src = 4096 + (n0 - 12288); else { src = 0; zero = true; }
            transpose_item(INP(8) + (size_t)l * 2048 * INW, INW, src, kb * 64, WinT + (size_t)l * ZW * 2048, 2048, n0, zero, scr, lane);
        } else {
            const int r = it - I_IN, kb = r / 64, nb = r % 64;
            transpose_item(INP(19) + (size_t)l * 4096 * 2048, 2048, nb * 32, kb * 64, WoutT + (size_t)l * 2048 * 4096, 4096, nb * 32, false, scr, lane, kb >= 32 ? INP(18) + l * 2048 + (kb * 64 - 2048) : (const float*)nullptr);
        }
    }
}

__device__ __forceinline__ void phase_prologue(const Args& a, unsigned char* ws, const int bid, LAS unsigned char* lds, int tid, int wave, int lane) {
    const int G = gridDim.x;
    {
        LAS float* sc = (LAS float*)lds;
        LAS float* part = (LAS float*)(lds + 40960);
        const float* c = INP(1); const float* cctx = INP(3);
        for (int i = tid; i < 5 * 2048; i += 512) { const int s = i >> 11, k = i & 2047; const float cv = s < 4 ? c[s * 2048 + k] : cctx[k]; sc[i] = silu_f(cv); }
        __syncthreads();
        float* mod = (float*)(ws + WS_MOD);
        for (int item = bid; item < 192; item += G) {
            const int l = item / 48, cb = item % 48, col0 = cb * 128;
            const float* W = INP(4) + (size_t)l * 2048 * 6144 + col0 + lane * 2;
            float acc[5][2];
#pragma unroll
            for (int s = 0; s < 5; ++s) { acc[s][0] = 0.f; acc[s][1] = 0.f; }
            const int k0 = wave * 256;
#pragma unroll 8
            for (int k = k0; k < k0 + 256; ++k) { const f32x2 w = __builtin_nontemporal_load((const f32x2*)(W + (size_t)k * 6144));
#pragma unroll
                for (int s = 0; s < 5; ++s) { const float sv = sc[s * 2048 + k]; acc[s][0] += sv * w.x; acc[s][1] += sv * w.y; } }
#pragma unroll
            for (int s = 0; s < 5; ++s) { part[(wave * 5 + s) * 128 + lane * 2] = acc[s][0]; part[(wave * 5 + s) * 128 + lane * 2 + 1] = acc[s][1]; }
            __syncthreads();
            for (int i = tid; i < 640; i += 512) { const int s = i >> 7, cc = i & 127; float v = INP(5)[l * 6144 + col0 + cc];
#pragma unroll
                for (int w = 0; w < 8; ++w) v += part[(w * 5 + s) * 128 + cc];
                const int col = col0 + cc;
                if (col >= 4096) v *= INP(7)[l * 2048 + col - 4096]; else if (col >= 2048) v = (1.f + v) * INP(6)[l * 2048 + col - 2048];
                mod[(size_t)(l * 5 + s) * 6144 + col] = v; }
            __syncthreads();
        }
    }
    {
        bf16_t* wsb = (bf16_t*)(ws + WS_WSB); const float* w_s = INP(16);
        for (int i = (bid * 512 + tid) * 4; i < 4 * 16 * 16384; i += G * 512 * 4) { const f32x4 v = *(const f32x4*)(w_s + i);
            u32x2 o; o.x = cvt_pk_bf16(v.x, v.y); o.y = cvt_pk_bf16(v.z, v.w); *(u32x2*)(wsb + i) = o; }
    }
    convert_layer_weights(a, ws, 0, bid * 8 + wave, G * 8, lds, wave, lane);
}

__device__ __forceinline__ void phase_A(const Args& a, unsigned char* ws, const int bid, int l, int wave, int lane) {
    const int gw = bid * 8 + wave, NGW = gridDim.x * 8;
    const float* mod = (const float*)(ws + WS_MOD);
    float* ctxall = (float*)(ws + WS_CTX);
    bf16_t* hx = (bf16_t*)(ws + WS_HX);
    const bf16_t* z = (const bf16_t*)(ws + WS_Z);
#pragma unroll 1
    for (int seg = (l == 4 ? 1 : 0); seg < 5; ++seg) {
        const int s = seg == 0 ? 4 : seg - 1, rbeg = seg == 0 ? 0 : TCTX + (seg - 1) * SEQ, rend = seg == 0 ? TCTX : rbeg + SEQ;
        f32x4 G2[8], S2[8], SH[8];
        if (l >= 1) { const float* gp = mod + (size_t)((l - 1) * 5 + s) * 6144 + 4096 + lane * 4;
#pragma unroll
            for (int j = 0; j < 8; ++j) G2[j] = *(const f32x4*)(gp + j * 256); }
        if (l < 4) { const float* sp = mod + (size_t)(l * 5 + s) * 6144 + lane * 4;
#pragma unroll
            for (int j = 0; j < 8; ++j) { SH[j] = *(const f32x4*)(sp + j * 256); S2[j] = *(const f32x4*)(sp + 2048 + j * 256); } }
#pragma unroll 1
        for (int r = rbeg + gw; r < rend; r += NGW) {
            if (l < 4 && lane == 0) { ((float*)(ws + WS_RVS))[r] = 0.f; ((float*)(ws + WS_YBS))[r] = 0.f; }
            const float* src; float* dst;
            if (r < TCTX) { dst = ctxall + (size_t)r * D; src = (l <= 1) ? INP(2) + (size_t)r * D : dst; }
            else { dst = a.out + (size_t)(r - TCTX) * D; src = (l <= 1) ? INP(0) + (size_t)(r - TCTX) * D : dst; }
            f32x4 xv[8];
#pragma unroll
            for (int j = 0; j < 8; ++j) xv[j] = __builtin_nontemporal_load((const f32x4*)(src + j * 256 + lane * 4));
            if (l >= 1) {
                const bf16_t* orow = z + (size_t)r * ZW;
                f32x4 ov[8]; float ss = 0.f;
                if (r < TCTX) {
                    const float* pp = (const float*)(ws + WS_XBC) + (size_t)r * 2048 + lane * 4;
#pragma unroll
                    for (int j = 0; j < 8; ++j) { f32x4 acc4 = *(const f32x4*)(pp + j * 256);
#pragma unroll
                        for (int kc = 1; kc < 8; ++kc) acc4 = acc4 + *(const f32x4*)(pp + (size_t)kc * TCTX * 2048 + j * 256);
                        ov[j] = acc4; }
                } else {
#pragma unroll
                    for (int j = 0; j < 8; ++j) { const u32x2 ob = __builtin_nontemporal_load((const u32x2*)(orow + j * 256 + lane * 4)); ov[j] = (f32x4){bflo(ob.x), bfhi(ob.x), bflo(ob.y), bfhi(ob.y)}; }
                }
#pragma unroll
                for (int j = 0; j < 8; ++j) ss += (ov[j].x * ov[j].x + ov[j].y * ov[j].y) + (ov[j].z * ov[j].z + ov[j].w * ov[j].w);
                const float ro = rsqrtf(wave_sum(ss) * (1.f / D) + EPS);
#pragma unroll
                for (int j = 0; j < 8; ++j) { xv[j] = xv[j] + G2[j] * (ov[j] * ro); __builtin_nontemporal_store(xv[j], (f32x4*)(dst + j * 256 + lane * 4)); }
            }
            if (l < 4) {
                float ss = 0.f;
#pragma unroll
                for (int j = 0; j < 8; ++j) ss += (xv[j].x * xv[j].x + xv[j].y * xv[j].y) + (xv[j].z * xv[j].z + xv[j].w * xv[j].w);
                const float rx = rsqrtf(wave_sum(ss) * (1.f / D) + EPS);
#pragma unroll
                for (int j = 0; j < 8; ++j) { const int col = j * 256 + lane * 4;
                    const f32x4 hv = (xv[j] * rx) * S2[j] + SH[j];
                    u32x2 o; o.x = cvt_pk_bf16(hv.x, hv.y); o.y = cvt_pk_bf16(hv.z, hv.w);
                    *(u32x2*)(hx + (size_t)r * D + col) = o; }
            }
        }
    }
}

__device__ __forceinline__ void mlp_phase(const Args& a, unsigned char* ws, const int bid, int l, LAS unsigned char* lds, int tid, int wave, int lane) {
    bf16_t* z = (bf16_t*)(ws + WS_Z);
    const bf16_t* wsb = (const bf16_t*)(ws + WS_WSB) + (size_t)l * 16 * 16384;
    const float* rvs = (const float*)(ws + WS_RVS); float* ybs = (float*)(ws + WS_YBS);
    const float* g_v = INP(15) + l * 2048; const float* b_s = INP(17) + l * 16 * 128;
    LAS unsigned char* L_W = lds; LAS unsigned char* L_V = lds + 34816;
    const int fr = lane & 15, fq = lane >> 4, wr = wave >> 1, wc = wave & 1;
    const int G = gridDim.x;
    u32x4 tw[4], tv[4]; float trk[4]; f32x4 tg0, tg1;
    const bool wfixed = (G & 15) == 0;
#define MLP_ISSUE(it) do { const int _gc = (it) >> 4, _g = (it) & 15; \
        _Pragma("unroll") for (int i = 0; i < 4; ++i) { const int p = tid + i * 512, r = p >> 4, cp = p & 15; \
            if (!wfixed) tw[i] = *(const u32x4*)(wsb + (size_t)_g * 16384 + r * 128 + cp * 8); \
            tv[i] = __builtin_nontemporal_load((const u32x4*)(z + (size_t)(_gc * 128 + r) * ZW + ZC_V + _g * 128 + cp * 8)); \
            trk[i] = rvs[_gc * 128 + r]; } \
        tg0 = *(const f32x4*)(g_v + _g * 128 + (tid & 15) * 8); tg1 = *(const f32x4*)(g_v + _g * 128 + (tid & 15) * 8 + 4); } while (0)
    if (wfixed && bid < NCH * 16) {
#pragma unroll
        for (int i = 0; i < 4; ++i) { const int p = tid + i * 512, r = p >> 4, cp = p & 15; *(LAS u32x4*)(L_W + r * 272 + cp * 16) = *(const u32x4*)(wsb + (size_t)(bid & 15) * 16384 + r * 128 + cp * 8); } }
    if (bid < NCH * 16) MLP_ISSUE(bid);
#pragma unroll 1
    for (int it = bid; it < NCH * 16; it += G) {
        const int gc = it >> 4, g = it & 15, row0 = gc * 128;
#pragma unroll
        for (int i = 0; i < 4; ++i) { const int p = tid + i * 512, r = p >> 4, cp = p & 15;
            if (!wfixed) *(LAS u32x4*)(L_W + r * 272 + cp * 16) = tw[i];
            float f[8]; unpack8(tv[i], f); const float rk = rsqrtf(trk[i] * (1.f / 2048.f) + EPS);
            const f32x4 g0 = tg0, g1 = tg1;
            float o[8] = {f[0] * rk * g0.x, f[1] * rk * g0.y, f[2] * rk * g0.z, f[3] * rk * g0.w, f[4] * rk * g1.x, f[5] * rk * g1.y, f[6] * rk * g1.z, f[7] * rk * g1.w};
            *(LAS u32x4*)(L_V + offb(r, cp)) = pack8(o); }
        u32x4 pu[2][2]; float pbias[2];
#pragma unroll
        for (int i = 0; i < 2; ++i) { const int q = (2 * wr + i) * 16 + fr; const bf16_t* zr = z + (size_t)(row0 + q) * ZW; pbias[i] = b_s[g * 128 + q];
#pragma unroll
            for (int m = 0; m < 2; ++m) { const int d0 = g * 128 + 32 * (2 * wc + m) + 8 * fq; pu[i][m] = __builtin_nontemporal_load((const u32x4*)(zr + ZC_U + d0)); } }
        LDS_BARRIER();
        if (it + G < NCH * 16) MLP_ISSUE(it + G);
        f32x4 acc[2][4];
#pragma unroll
        for (int i = 0; i < 2; ++i)
#pragma unroll
            for (int j = 0; j < 4; ++j) acc[i][j] = (f32x4){0.f, 0.f, 0.f, 0.f};
#pragma unroll
        for (int s = 0; s < 4; ++s) { bf16x8 wf[2], vf[4];
#pragma unroll
            for (int i = 0; i < 2; ++i) wf[i] = *(const LAS bf16x8*)(L_W + ((2 * wr + i) * 16 + fr) * 272 + s * 64 + fq * 16);
#pragma unroll
            for (int j = 0; j < 4; ++j) vf[j] = ldfrag_tr_bp(L_V, 32 * s, 4 * wc + j, lane);
            __builtin_amdgcn_sched_barrier(0);
#pragma unroll
            for (int i = 0; i < 2; ++i)
#pragma unroll
                for (int j = 0; j < 4; ++j) acc[i][j] = MFMA16(vf[j], wf[i], acc[i][j]);
            __builtin_amdgcn_sched_barrier(0); }
#pragma unroll
        for (int i = 0; i < 2; ++i) { const int q = (2 * wr + i) * 16 + fr; const float bias = pbias[i];
            bf16_t* zr = z + (size_t)(row0 + q) * ZW; float ss = 0.f;
#pragma unroll
            for (int m = 0; m < 2; ++m) { const int d0 = g * 128 + 32 * (2 * wc + m) + 8 * fq;
                float uf[8]; unpack8(pu[i][m], uf);
                float o[8];
#pragma unroll
                for (int r = 0; r < 4; ++r) { o[r] = uf[r] * (acc[i][2 * m][r] + bias); o[4 + r] = uf[4 + r] * (acc[i][2 * m + 1][r] + bias); }
#pragma unroll
                for (int e = 0; e < 8; ++e) ss += o[e] * o[e];
                *(u32x4*)(zr + ZC_U + d0) = pack8(o); }
            ss += __shfl_xor(ss, 16); ss += __shfl_xor(ss, 32);
            if (fq == 0) unsafeAtomicAdd(ybs + row0 + q, ss); }
        LDS_BARRIER();
    }
#undef MLP_ISSUE
}

__device__ __forceinline__ void conv_stream(const Args& a, unsigned char* ws, const int bid, int l, int tid) {
    const bf16_t* z = (const bf16_t*)(ws + WS_Z); bf16_t* xbc = (bf16_t*)(ws + WS_XBC);
    const int c0 = tid * 8;
    const float* cw = INP(9) + (size_t)l * 5 * 4096 + c0; const float* cbias = INP(10) + l * 4096 + c0;
    float w[5][8], bias[8];
#pragma unroll
    for (int k = 0; k < 5; ++k) { const f32x4 w0 = *(const f32x4*)(cw + k * 4096), w1 = *(const f32x4*)(cw + k * 4096 + 4);
        w[k][0] = w0.x; w[k][1] = w0.y; w[k][2] = w0.z; w[k][3] = w0.w; w[k][4] = w1.x; w[k][5] = w1.y; w[k][6] = w1.z; w[k][7] = w1.w; }
    { const f32x4 b0 = *(const f32x4*)cbias, b1 = *(const f32x4*)(cbias + 4); bias[0] = b0.x; bias[1] = b0.y; bias[2] = b0.z; bias[3] = b0.w; bias[4] = b1.x; bias[5] = b1.y; bias[6] = b1.z; bias[7] = b1.w; }
    for (int tg = bid; tg < T / 8; tg += gridDim.x) {
        const int tb = tg * 8;
        bool lo_ok, hi_ok;
        if (tb < TCTX) { lo_ok = (tb & 255) != 0; hi_ok = ((tb + 8) & 255) != 0; }
        else { lo_ok = ((tb - TCTX) & 63) != 0; hi_ok = ((tb + 8 - TCTX) & 63) != 0; }
        u32x4 rows[12];
#pragma unroll
        for (int j = 0; j < 12; ++j) { const bool ok = (j >= 2 && j < 10) || (j < 2 && lo_ok) || (j >= 10 && hi_ok);
            rows[j] = ok ? __builtin_nontemporal_load((const u32x4*)(z + (size_t)(tb - 2 + j) * ZW + c0)) : (u32x4){0u, 0u, 0u, 0u}; }
#pragma unroll
        for (int e = 0; e < 8; ++e) { float acc[8];
#pragma unroll
            for (int c = 0; c < 8; ++c) acc[c] = bias[c];
#pragma unroll
            for (int k = 0; k < 5; ++k) { float f[8]; unpack8(rows[e + k], f);
#pragma unroll
                for (int c = 0; c < 8; ++c) acc[c] += w[k][c] * f[c]; }
#pragma unroll
            for (int c = 0; c < 8; ++c) acc[c] = silu_f(acc[c]);
            *(u32x4*)(xbc + (size_t)(tb + e) * 4096 + c0) = pack8(acc); }
    }
}

__device__ __forceinline__ void phase_C0(const Args& a, unsigned char* ws, const int bid, int l, LAS unsigned char* lds, int tid, int wave, int lane) {
    const int G = gridDim.x;
    { const bf16_t* z = (const bf16_t*)(ws + WS_Z); float* DT = (float*)(ws + WS_DT); const float* dtb = INP(11) + l * 64;
      for (int idx = bid * 512 + tid; idx < T * 64; idx += G * 512) { const int t = idx >> 6, j = idx & 63;
          const float xr = bf1(z[(size_t)t * ZW + ZC_DT + j]) + dtb[j];
          const float e = __expf(-fabsf(xr)), u = 1.f + e;
          const float l1p = (u == 1.f) ? e : __logf(u) * e * __builtin_amdgcn_rcpf(u - 1.f);
          DT[idx] = fmaxf(xr, 0.f) + l1p; } }
    mlp_phase(a, ws, bid, l, lds, tid, wave, lane);
    conv_stream(a, ws, bid, l, tid);
#ifdef CONV_REP
    conv_stream(a, ws, bid, l, tid);
#endif
}

__device__ __forceinline__ void phase_C1(const Args& a, unsigned char* ws, const int bid, int l, LAS unsigned char* lds, int tid, int wave, int lane) {
    bf16_t* z = (bf16_t*)(ws + WS_Z);
    const bf16_t* xbc = (const bf16_t*)(ws + WS_XBC);
    const float* DT = (const float*)(ws + WS_DT);
    LAS unsigned char* L_C = lds; LAS unsigned char* L_B = lds + 34816; LAS unsigned char* L_M = lds + 69632; LAS unsigned char* L_X = lds + 104448; LAS unsigned char* L_H = lds + 122880;
    LAS float* cs = (LAS float*)(lds + 140288); LAS float* dtv = cs + 128; LAS float* wgt = cs + 256; LAS float* ecs = cs + 384; LAS float* f2dt = cs + 512; LAS float* refarr = cs + 640; LAS float* totp = cs + 656;
    const int fr = lane & 15, fq = lane >> 4, wr = wave >> 1, wc = wave & 1;
    const int qt = wave < 4 ? wave : 11 - wave;
    const int rb = fr * 272 + fq * 16;
    const int trB = (8 * fq + (fr >> 2)) * 272 + 8 * (lane & 3);
    const int trX = (8 * fq + (fr >> 2)) * 144 + 8 * (lane & 3);
    const int trXp = (8 * fq + (fr >> 2)) * 144 + 16 * (lane & 3);
    const int rbH = (8 * (fr >> 2) + (fr & 3)) * 272 + fq * 16;
    const unsigned offCB = (unsigned)(tid >> 4) * 4096u + (unsigned)(tid & 15) * 8u, offX = (unsigned)(tid >> 3) * 4096u + (unsigned)(tid & 7) * 8u;
    const int wCB = (tid >> 4) * 272 + (tid & 15) * 16, wX = (tid >> 3) * 144 + (tid & 7) * 16;
#define TRB(base, krow0, col0, t) __builtin_amdgcn_ds_read_tr16_b64_v4i16((LAS s16x4*)((base) + trB + ((krow0) + 4 * (t)) * 272 + (col0) * 2))
#define TRX(base, krow0, col0, t) __builtin_amdgcn_ds_read_tr16_b64_v4i16((LAS s16x4*)((base) + trX + ((krow0) + 4 * (t)) * 144 + (col0) * 2))
    for (int item = bid; item < 256; item += gridDim.x) {
        const int combo = (item & 7) * 8 + (item >> 5), hq = (item >> 3) & 3;
        const int b = combo >> 4, g = (combo >> 1) & 7, dir = combo & 1, h = 4 * g + hq;
        const float Acoef = -__expf(INP(12)[l * 64 + dir * 32 + h]);
        const float dskip = INP(13)[l * 32 + h];
        f32x4 Hacc[4];
#pragma unroll
        for (int j = 0; j < 4; ++j) Hacc[j] = (f32x4){0.f, 0.f, 0.f, 0.f};
        for (int i = tid; i < 17408 / 4; i += 512) ((LAS unsigned*)L_H)[i] = 0u;
        u32x4 pc[4], pb[4], px[2]; float pd0 = 0.f, pd1 = 0.f;
#define SSD_GC(step) ((dir == 0) ? ((step) < 2 ? 2 * b + (step) : 8 + b * 64 + ((step) - 2)) : ((step) < 2 ? 2 * b + (1 - (step)) : 8 + b * 64 + (65 - (step))))
#define SSD_ISSUE(step) do { const int _r0 = SSD_GC(step) * 128; const bf16_t* _cb = xbc + (size_t)_r0 * 4096 + 2048 + g * 128; const bf16_t* _xb = xbc + (size_t)_r0 * 4096 + h * 64; \
            _Pragma("unroll") for (int i = 0; i < 4; ++i) { pc[i] = *(const u32x4*)(_cb + 1024 + (size_t)i * 32 * 4096 + offCB); pb[i] = *(const u32x4*)(_cb + (size_t)i * 32 * 4096 + offCB); } \
            _Pragma("unroll") for (int i = 0; i < 2; ++i) px[i] = __builtin_nontemporal_load((const u32x4*)(_xb + (size_t)i * 64 * 4096 + offX)); \
            if (wave == 0) { pd0 = DT[(size_t)(_r0 + 2 * lane) * 64 + dir * 32 + h]; pd1 = DT[(size_t)(_r0 + 2 * lane + 1) * 64 + dir * 32 + h]; } } while (0)
        SSD_ISSUE(0);
#pragma unroll 1
        for (int step = 0; step < 66; ++step) {
            const int row0 = SSD_GC(step) * 128;
#pragma unroll
            for (int i = 0; i < 4; ++i) { *(LAS u32x4*)(L_C + wCB + i * 32 * 272) = pc[i]; *(LAS u32x4*)(L_B + wCB + i * 32 * 272) = pb[i]; }
#pragma unroll
            for (int i = 0; i < 2; ++i) *(LAS u32x4*)(L_X + wX + i * 64 * 144) = px[i];
            if (wave == 0) {
                const int t0 = 2 * lane;
                const float d0 = pd0, d1 = pd1;
                const float a0 = d0 * Acoef, a1 = d1 * Acoef, pair = a0 + a1; const float incl = wave_incl_scan(pair);
                const float tot = __builtin_bit_cast(float, __builtin_amdgcn_readlane(__builtin_bit_cast(int, incl), 63)), excl = incl - pair;
                float c0v, c1v, ref;
                if (dir == 0) { c0v = excl + a0; c1v = incl; ref = __shfl(c1v, (lane & ~7) + 7); }
                else { c0v = tot - excl; c1v = tot - incl + a1; ref = __shfl(c0v, lane & ~7); }
                cs[t0] = c0v; cs[t0 + 1] = c1v; dtv[t0] = d0; dtv[t0 + 1] = d1;
                wgt[t0] = d0 * __expf(tot - c0v); wgt[t0 + 1] = d1 * __expf(tot - c1v);
                ecs[t0] = __expf(c0v); ecs[t0 + 1] = __expf(c1v);
                f2dt[t0] = d0 * __expf(ref - c0v); f2dt[t0 + 1] = d1 * __expf(ref - c1v);
                if ((lane & 7) == 0) refarr[lane >> 3] = ref;
                if (lane == 0) totp[0] = tot;
            }
            LDS_BARRIER();
            if (step + 1 < 66) SSD_ISSUE(step + 1);
            f32x4 accA[8], accC[4];
#pragma unroll
            for (int j = 0; j < 8; ++j) accA[j] = (f32x4){0.f, 0.f, 0.f, 0.f};
#pragma unroll
            for (int j = 0; j < 4; ++j) accC[j] = (f32x4){0.f, 0.f, 0.f, 0.f};
            {
                bf16x8 cqv[2], bq[2][4], hq[2][2];
#define SSD_LDH(buf, h_) do { const int _s = (h_) >> 1, _hf = (h_) & 1; if (_hf == 0) cqv[_s & 1] = *(const LAS bf16x8*)(L_C + qt * (16 * 272) + rb + _s * 64); \
                    _Pragma("unroll") for (int k = 0; k < 4; ++k) bq[buf][k] = *(const LAS bf16x8*)(L_B + (4 * _hf + k) * (16 * 272) + rb + _s * 64); \
                    _Pragma("unroll") for (int p = 0; p < 2; ++p) hq[buf][p] = *(const LAS bf16x8*)(L_H + (32 * _hf + 4 * p) * 272 + rbH + _s * 64); } while (0)
                SSD_LDH(0, 0);
#pragma unroll
                for (int h2 = 0; h2 < 8; ++h2) { const int cb = h2 & 1, s_ = h2 >> 1, hf_ = h2 & 1;
                    if (h2 < 7) SSD_LDH(cb ^ 1, h2 + 1);
                    __builtin_amdgcn_sched_barrier(0);
#pragma unroll
                    for (int k = 0; k < 4; ++k) accA[4 * hf_ + k] = MFMA16(bq[cb][k], cqv[s_ & 1], accA[4 * hf_ + k]);
#pragma unroll
                    for (int p = 0; p < 2; ++p) accC[2 * hf_ + p] = MFMA16(hq[cb][p], cqv[s_ & 1], accC[2 * hf_ + p]);
                    __builtin_amdgcn_sched_barrier(0); }
#undef SSD_LDH
            }
            { const float etot = __expf(totp[0]);
#pragma unroll
              for (int j = 0; j < 4; ++j) Hacc[j] = Hacc[j] * etot;
#pragma unroll
              for (int s = 0; s < 4; ++s) { const s16x4 xlo = TRX(L_X, 32 * s, 16 * wr, 0), xhi = TRX(L_X, 32 * s, 16 * wr, 1);
                  const f32x4 w0 = *(const LAS f32x4*)(wgt + s * 32 + fq * 8), w1 = *(const LAS f32x4*)(wgt + s * 32 + fq * 8 + 4);
                  s16x4 blo[4], bhi[4];
#pragma unroll
                  for (int j = 0; j < 4; ++j) { blo[j] = TRB(L_B, 32 * s, 16 * (4 * wc + j), 0); bhi[j] = TRB(L_B, 32 * s, 16 * (4 * wc + j), 1); }
                  __builtin_amdgcn_sched_barrier(0);
                  const u32x2 xl = __builtin_bit_cast(u32x2, xlo), xh = __builtin_bit_cast(u32x2, xhi);
                  u32x4 xs; xs.x = cvt_pk_bf16(bflo(xl.x) * w0.x, bfhi(xl.x) * w0.y); xs.y = cvt_pk_bf16(bflo(xl.y) * w0.z, bfhi(xl.y) * w0.w);
                  xs.z = cvt_pk_bf16(bflo(xh.x) * w1.x, bfhi(xh.x) * w1.y); xs.w = cvt_pk_bf16(bflo(xh.y) * w1.z, bfhi(xh.y) * w1.w);
                  const bf16x8 xq = __builtin_bit_cast(bf16x8, xs);
#pragma unroll
                  for (int j = 0; j < 4; ++j) { const bf16x8 bt = (bf16x8){blo[j].x, blo[j].y, blo[j].z, blo[j].w, bhi[j].x, bhi[j].y, bhi[j].z, bhi[j].w};
                      Hacc[j] = MFMA16(bt, xq, Hacc[j]); }
                  __builtin_amdgcn_sched_barrier(0); } }
            { const int q = qt * 16 + fr; const float csq = cs[q], eq = ecs[q];
              f32x4 gd = accA[0];
#pragma unroll
              for (int kt = 1; kt < 8; ++kt) { const bool is = (kt == qt); gd.x = is ? accA[kt].x : gd.x; gd.y = is ? accA[kt].y : gd.y; gd.z = is ? accA[kt].z : gd.z; gd.w = is ? accA[kt].w : gd.w; }
#pragma unroll
              for (int kt = 0; kt < 8; ++kt) { const int k0 = kt * 16 + fq * 4;
                  const bool kept = dir == 0 ? (kt < qt) : (kt > qt);
                  const float f1 = __expf(csq - refarr[kt]); const f32x4 f2 = *(const LAS f32x4*)(f2dt + k0);
                  float m[4];
#pragma unroll
                  for (int r = 0; r < 4; ++r) m[r] = kept ? accA[kt][r] * f1 * f2[r] : 0.f;
                  u32x2 o; o.x = cvt_pk_bf16(m[0], m[1]); o.y = cvt_pk_bf16(m[2], m[3]);
                  *(LAS u32x2*)(L_M + q * 272 + k0 * 2) = o; }
              { const int k0 = qt * 16 + fq * 4; const f32x4 ck = *(const LAS f32x4*)(cs + k0), dk = *(const LAS f32x4*)(dtv + k0); float m[4];
#pragma unroll
                for (int r = 0; r < 4; ++r) { const int kk = k0 + r; const bool keep = dir == 0 ? (kk <= q) : (kk >= q); m[r] = keep ? gd[r] * __expf(csq - ck[r]) * dk[r] : 0.f; }
                u32x2 o; o.x = cvt_pk_bf16(m[0], m[1]); o.y = cvt_pk_bf16(m[2], m[3]);
                *(LAS u32x2*)(L_M + q * 272 + k0 * 2) = o; }
              f32x4 accB[4];
#pragma unroll
              for (int j = 0; j < 4; ++j) accB[j] = (f32x4){0.f, 0.f, 0.f, 0.f};
#pragma unroll
              for (int s = 0; s < 4; ++s) { const bf16x8 mq = *(const LAS bf16x8*)(L_M + qt * (16 * 272) + rb + s * 64);
                  s16x4 xlo[4], xhi[4];
#pragma unroll
                  for (int pt = 0; pt < 4; ++pt) { xlo[pt] = __builtin_amdgcn_ds_read_tr16_b64_v4i16((LAS s16x4*)(L_X + trXp + (32 * s) * 144 + (32 * (pt >> 1) + 4 * (pt & 1)) * 2));
                      xhi[pt] = __builtin_amdgcn_ds_read_tr16_b64_v4i16((LAS s16x4*)(L_X + trXp + (32 * s + 4) * 144 + (32 * (pt >> 1) + 4 * (pt & 1)) * 2)); }
                  __builtin_amdgcn_sched_barrier(0);
#pragma unroll
                  for (int pt = 0; pt < 4; ++pt) { const bf16x8 xf = (bf16x8){xlo[pt].x, xlo[pt].y, xlo[pt].z, xlo[pt].w, xhi[pt].x, xhi[pt].y, xhi[pt].z, xhi[pt].w}; accB[pt] = MFMA16(xf, mq, accB[pt]); }
                  __builtin_amdgcn_sched_barrier(0); }
              bf16_t* yrow = z + (size_t)(row0 + q) * ZW + dir * 2048 + h * 64 + 8 * fq;
#pragma unroll
              for (int m = 0; m < 2; ++m) { float y[8];
#pragma unroll
                  for (int r = 0; r < 4; ++r) { y[r] = accB[2 * m][r] + eq * accC[2 * m][r]; y[4 + r] = accB[2 * m + 1][r] + eq * accC[2 * m + 1][r]; }
                  if (dir == 0) { const u32x4 xv = *(const LAS u32x4*)(L_X + q * 144 + (32 * m + 8 * fq) * 2); float xf8[8]; unpack8(xv, xf8);
#pragma unroll
                      for (int e = 0; e < 8; ++e) y[e] += dskip * xf8[e]; }
                  *(u32x4*)(yrow + 32 * m) = pack8(y); } }
            LDS_BARRIER();
#pragma unroll
            for (int j = 0; j < 4; ++j) { u32x2 o; o.x = cvt_pk_bf16(Hacc[j][0], Hacc[j][1]); o.y = cvt_pk_bf16(Hacc[j][2], Hacc[j][3]);
                *(LAS u32x2*)(L_H + (wr * 16 + fr) * 272 + ((4 * wc + j) * 16 + fq * 4) * 2) = o; }
        }
        __syncthreads();
#undef SSD_GC
#undef SSD_ISSUE
    }
#undef TRB
#undef TRX
}

__device__ __forceinline__ void phase_C2(const Args& a, unsigned char* ws, const int bid, int l, int wave, int lane) {
    bf16_t* z = (bf16_t*)(ws + WS_Z);
    const float* g_ssd = INP(14) + l * 2048; const float* g_mlp = INP(18) + l * 2048;
    const int gw = bid * 8 + wave, NGW = gridDim.x * 8;
    f32x4 gs[8];
#pragma unroll
    for (int j = 0; j < 4; ++j) { gs[2 * j] = *(const f32x4*)(g_ssd + j * 512 + lane * 8); gs[2 * j + 1] = *(const f32x4*)(g_ssd + j * 512 + lane * 8 + 4); }
    for (int r = gw + (l == 3 ? TCTX : 0); r < T; r += NGW) {
        bf16_t* zr = z + (size_t)r * ZW;
        const float ybr = ((const float*)(ws + WS_YBS))[r];
        float yv[32]; float ss = 0.f;
#pragma unroll
        for (int j = 0; j < 4; ++j) { const int col = j * 512 + lane * 8;
            const u32x4 yf = __builtin_nontemporal_load((const u32x4*)(zr + col)), yb = __builtin_nontemporal_load((const u32x4*)(zr + 2048 + col)), zs = __builtin_nontemporal_load((const u32x4*)(zr + ZC_ZSSD + col));
            float f0[8], f1[8], f2[8]; unpack8(yf, f0); unpack8(yb, f1); unpack8(zs, f2);
#pragma unroll
            for (int e = 0; e < 8; ++e) { const float y = (f0[e] + f1[e]) * silu_f(f2[e]); yv[j * 8 + e] = y; ss += y * y; } }
        const float ra = rsqrtf(wave_sum(ss) * (1.f / 2048.f) + EPS) * sqrtf(ybr * (1.f / 2048.f) + EPS);
#pragma unroll
        for (int j = 0; j < 4; ++j) { const int col = j * 512 + lane * 8;
            const f32x4 g0 = gs[2 * j], g1 = gs[2 * j + 1];
            float o[8] = {yv[j * 8 + 0] * ra * g0.x, yv[j * 8 + 1] * ra * g0.y, yv[j * 8 + 2] * ra * g0.z, yv[j * 8 + 3] * ra * g0.w,
                          yv[j * 8 + 4] * ra * g1.x, yv[j * 8 + 5] * ra * g1.y, yv[j * 8 + 6] * ra * g1.z, yv[j * 8 + 7] * ra * g1.w};
            *(u32x4*)(zr + ZC_ZSSD + col) = pack8(o); }
    }
}

__global__ void __launch_bounds__(512, 2) mk_fwd(Args a) {
    extern __shared__ __attribute__((aligned(16))) unsigned char lds_raw[];
    LAS unsigned char* lds = (LAS unsigned char*)lds_raw;
    cg::grid_group grid = cg::this_grid();
    { LAS unsigned* stw = (LAS unsigned*)(lds + LDS_BAR_OFF); if (threadIdx.x < 4) stw[threadIdx.x] = 0u; }
    __syncthreads();
    (void)xcd_barrier_post((unsigned*)(a.ws + WS_BAR), (volatile LAS unsigned*)(lds + LDS_BAR_OFF));
    int ph = a.ph_lo, rep = 0, nsync = 0; bool first = true;
#ifdef SYNC_PROBE
    for (int i = 0; i < 100; ++i) { XcdBarrier xb; xb.bar = (unsigned*)(a.ws + WS_BAR); xb.x = xb_xcc_id(); xb.st = (volatile LAS unsigned*)(lds + LDS_BAR_OFF); xcd_barrier(xb); }
#endif
#pragma unroll 1
    while (ph < a.ph_hi) {
        if (!first) { if (nsync == 0) grid.sync(); else { XcdBarrier xb; xb.bar = (unsigned*)(a.ws + WS_BAR); xb.x = xb_xcc_id(); xb.st = (volatile LAS unsigned*)(lds + LDS_BAR_OFF); xcd_barrier(xb); } ++nsync; }
        first = false;
        int tid = threadIdx.x; asm volatile("" : "+v"(tid));
        int bid = blockIdx.x; asm volatile("" : "+s"(bid));
        long zo = 0; asm volatile("" : "+s"(zo)); unsigned char* ws = a.ws + zo;
        const int wave = __builtin_amdgcn_readfirstlane(tid >> 6), lane = tid & 63;
        const int l = (ph - 1) / 6, sub = (ph - 1) % 6;
        if (ph == 0) phase_prologue(a, ws, bid, lds, tid, wave, lane);
        else if (sub == 0) phase_A(a, ws, bid, l, wave, lane);
        else if (sub == 1 || sub == 5) {
            pg8::Gemm g; void* cout; int ldc, mode;
            int tail = 0; g.A2 = nullptr; g.P2 = nullptr; const float* rbs = nullptr; const float* rbs_tail = nullptr;
            if (sub == 1) { g.A = (const bf16_t*)(ws + WS_HX); g.Bt = (const bf16_t*)(ws + WS_WIN) + (size_t)l * ZW * 2048; g.M = T; g.N = ZW; g.K = 2048; g.lda = 2048; cout = ws + WS_Z; ldc = ZW; mode = 0; }
            else { const int r0 = TCTX; rbs = (const float*)(ws + WS_YBS) + r0; rbs_tail = (const float*)(ws + WS_YBS);
                if (l < 3) { tail = 1; g.A2 = (const bf16_t*)(ws + WS_Z) + 4096; g.P2 = (float*)(ws + WS_XBC); }
                g.A = (const bf16_t*)(ws + WS_Z) + (size_t)r0 * ZW + 4096; g.Bt = (const bf16_t*)(ws + WS_WOUT) + (size_t)l * 2048 * 4096; g.M = T - r0; g.N = 2048; g.K = 4096; g.lda = ZW;
                cout = (bf16_t*)(ws + WS_Z) + (size_t)r0 * ZW; ldc = ZW; mode = 0; }
            pg8::StaticOrder S; S.init(g.M, g.N, (int)gridDim.x, bid, tail);
            pg8::gemm_phase(tid, lds, g, S, mode, cout, ldc, sub == 1 ? (float*)(ws + WS_RVS) : (float*)nullptr, rbs, rbs_tail);
            if (sub == 1 && l < 3) {
                const int nlong = (ZW / 256) * (T / 256) - ((ZW / 256) * (T / 256) / (int)gridDim.x) * (int)gridDim.x, G_ = (int)gridDim.x;
                if (nlong > 0 && nlong < G_) { if (bid >= nlong) convert_layer_weights(a, ws, l + 1, (bid - nlong) * 8 + wave, (G_ - nlong) * 8, lds, wave, lane); }
                else convert_layer_weights(a, ws, l + 1, bid * 8 + wave, G_ * 8, lds, wave, lane);
            }
        }
        else if (sub == 2) phase_C0(a, ws, bid, l, lds, tid, wave, lane);
        else if (sub == 3) phase_C1(a, ws, bid, l, lds, tid, wave, lane);
        else phase_C2(a, ws, bid, l, wave, lane);
        const int reps = ((ph > 0 && ((REP_MASK >> sub) & 1)) || (ph == 0 && (REP_MASK & 64)) || (ph > 0 && sub == 0 && l <= 1 && (REP_MASK & 128))) ? 2 : 1;
        if (++rep >= reps) { rep = 0; ++ph; }
    }
}

extern "C" void kernel_launch(void* const* d_in, const int* in_sizes, int n_in, void* d_out, int out_size, void* d_ws, size_t ws_size, hipStream_t stream) {
    static int grid = 0;
    if (grid == 0) {
        if (n_in != 20 || ws_size < WS_END) { fprintf(stderr, "kernel_launch: need 20 inputs and %zu bytes of workspace (got %d, %zu)\n", (size_t)WS_END, n_in, ws_size); grid = -1; return; }
        int dev = 0, cus = 0, per_cu = 0;
        hipGetDevice(&dev);
        hipDeviceGetAttribute(&cus, hipDeviceAttributeMultiprocessorCount, dev);
        hipFuncSetAttribute((const void*)mk_fwd, hipFuncAttributeMaxDynamicSharedMemorySize, LDS_BYTES);
        if (hipOccupancyMaxActiveBlocksPerMultiprocessor(&per_cu, (const void*)mk_fwd, 512, LDS_BYTES) != hipSuccess || per_cu < 1) per_cu = 1;
        (void)hipGetLastError();
        grid = cus * per_cu;
    }
    if (grid < 0) return;
    Args a{};
    for (int i = 0; i < 20; ++i) a.in[i] = (const float*)d_in[i];
    a.out = (float*)d_out; a.ws = (unsigned char*)d_ws; a.ph_lo = 0; a.ph_hi = 26;
    if (hipMemsetAsync((char*)d_ws + WS_BAR, 0, XCD_BAR_WORDS * sizeof(unsigned), stream) != hipSuccess) { fprintf(stderr, "kernel_launch: memset of the barrier words failed\n"); return; }
    void* args[] = {&a};
    hipError_t e = hipLaunchCooperativeKernel((const void*)mk_fwd, dim3(grid), dim3(512), args, LDS_BYTES, stream);
    if (e != hipSuccess) fprintf(stderr, "cooperative launch failed: %s (grid %d)\n", hipGetErrorString(e), grid);
}
```
